# Optimizing an MI355X kernel written in HIP

```python
import jax
import jax.numpy as jnp
from jax import lax
import numpy as np

D_MODEL = 2048
BATCH = 1
SEQ = 16384
DEPTH = 2

D_MIX = D_MODEL
D_FF = 5632
MACARON_WEIGHT = 0.5
NORM_EPS = 1e-6
ROPE_THETA = 10000.0
Q_BLOCK = 128

MLA_HEADS = 8
MLA_NOPE_DIM = 128
MLA_ROPE_DIM = 64
MLA_QK_DIM = MLA_NOPE_DIM + MLA_ROPE_DIM
MLA_V_DIM = 128
MLA_Q_LORA = 512
MLA_KV_LORA = 256

RWKV_HEAD = 64
RWKV_WIDTH = D_MIX - MLA_HEADS * MLA_V_DIM
RWKV_HEADS = RWKV_WIDTH // RWKV_HEAD
RWKV_W_LORA = 64
RWKV_A_LORA = 64
RWKV_G_LORA = 160
RWKV_GN_EPS = 64e-5

SWA_HEADS = 8
SWA_HEAD_DIM = 128
SWA_PATTERNS = ((128, 1), (512, 4), (2048, 16))

GLA_HEADS = 4
GLA_DK = 128
GLA_DV = (D_MIX - SWA_HEADS * SWA_HEAD_DIM) // GLA_HEADS
GLA_GATE_LORA = 16
GLA_GATE_NORMALIZER = 16.0
GLA_CHUNK = 64

MLA_COLS = (MLA_Q_LORA, MLA_KV_LORA, MLA_ROPE_DIM)
RWKV_COLS = (RWKV_WIDTH, RWKV_WIDTH, RWKV_WIDTH, RWKV_W_LORA, RWKV_A_LORA, RWKV_G_LORA)
SWA_COLS = (SWA_HEADS * SWA_HEAD_DIM,) * 3
GLA_COLS = (GLA_HEADS * GLA_DK, GLA_HEADS * GLA_DK, GLA_HEADS * GLA_DV, GLA_GATE_LORA, GLA_HEADS * GLA_DV)
RWKV_IN = sum(RWKV_COLS)
EVEN_IN = sum(MLA_COLS) + RWKV_IN
ODD_IN = sum(SWA_COLS) + sum(GLA_COLS)
N_EVEN = (DEPTH + 1) // 2
N_ODD = DEPTH // 2

kernel_name = 'hybrid_mla_rwkv7_dilated_gla_macaron'


def split_cols(p, widths):
    offs = [int(o) for o in np.cumsum(widths)[:-1]]
    return jnp.split(p, offs, axis=-1)


def rmsnorm(x, g):
    xf = x.astype(jnp.float32)
    y = xf * lax.rsqrt(jnp.mean(xf * xf, axis=-1, keepdims=True) + NORM_EPS)
    return (y * g.astype(jnp.float32)).astype(x.dtype)


def head_groupnorm(x, w, b, eps):
    xf = x.astype(jnp.float32)
    mu = jnp.mean(xf, axis=-1, keepdims=True)
    var = jnp.mean(jnp.square(xf - mu), axis=-1, keepdims=True)
    y = ((xf - mu) * lax.rsqrt(var + eps)).reshape(x.shape[0], x.shape[1], -1)
    return (y * w.astype(jnp.float32) + b.astype(jnp.float32)).astype(x.dtype)


def rope(x, positions):
    half = x.shape[-1] // 2
    inv_freq = ROPE_THETA ** (-jnp.arange(half, dtype=jnp.float32) / half)
    ang = positions.astype(jnp.float32)[..., None] * inv_freq
    cos, sin = jnp.cos(ang)[:, :, None, :], jnp.sin(ang)[:, :, None, :]
    xf = x.astype(jnp.float32)
    x1, x2 = xf[..., :half], xf[..., half:]
    return jnp.concatenate([x1 * cos - x2 * sin, x1 * sin + x2 * cos], axis=-1).astype(x.dtype)


def token_shift(p):
    return jnp.pad(p, ((0, 0), (1, 0), (0, 0)))[:, :-1]


def swiglu(x, w_gate, w_up, w_down):
    return (jax.nn.silu(x @ w_gate) * (x @ w_up)) @ w_down


def causal_blocked_attention(q, k, v, scale):
    B, S, H, Dk = q.shape
    nb = S // Q_BLOCK
    qb = q.reshape(B, nb, Q_BLOCK, H, Dk).transpose(1, 0, 2, 3, 4)
    kpos = jnp.arange(S)

    def one_block(args):
        qblk, start = args
        s = jnp.einsum('bqhd,bkhd->bhqk', qblk, k).astype(jnp.float32) * scale
        qpos = start + jnp.arange(Q_BLOCK)
        s = jnp.where(kpos[None, :] <= qpos[:, None], s, -jnp.inf)
        p = jax.nn.softmax(s, axis=-1)
        return jnp.einsum('bhqk,bkhd->bqhd', p.astype(v.dtype), v)

    out = lax.map(one_block, (qb, jnp.arange(nb) * Q_BLOCK))
    return out.transpose(1, 0, 2, 3, 4).reshape(B, S, H, v.shape[-1])


def rwkv7_recurrence(r, decay, k, v, a, b):
    B, S, H, N = r.shape

    def step(state, inp):
        r_t, w_t, k_t, v_t, a_t, b_t = inp
        sa = jnp.einsum('bhij,bhj->bhi', state, a_t)
        state = state * w_t[:, :, None, :] + sa[..., None] * b_t[:, :, None, :] + v_t[..., None] * k_t[:, :, None, :]
        return state, jnp.einsum('bhij,bhj->bhi', state, r_t)

    xs = tuple(t.astype(jnp.float32).transpose(1, 0, 2, 3) for t in (r, decay, k, v, a, b))
    _, y = lax.scan(step, jnp.zeros((B, H, N, N), jnp.float32), xs)
    return y.transpose(1, 0, 2, 3).astype(v.dtype)


def dilated_window_attention(q, k, v, window, dilation):
    B, S, H, Dh = q.shape
    blk = window // dilation
    span = blk * dilation
    s_pad = -(-S // span) * span
    L = s_pad // dilation
    nb = L // blk

    def to_blocks(t):
        t = jnp.pad(t, ((0, 0), (0, s_pad - S), (0, 0), (0, 0)))
        t = t.reshape(B, L, dilation, H, Dh).transpose(0, 2, 1, 3, 4)
        return t.reshape(B, dilation, nb, blk, H, Dh)

    def with_prev(t):
        prev = jnp.pad(t, ((0, 0), (0, 0), (1, 0), (0, 0), (0, 0), (0, 0)))[:, :, :-1]
        return jnp.concatenate([prev, t], axis=3)

    qb = to_blocks(q)
    kc, vc = with_prev(to_blocks(k)), with_prev(to_blocks(v))
    s = jnp.einsum('brnqhd,brnkhd->brnhqk', qb, kc).astype(jnp.float32) * Dh ** -0.5
    qi = jnp.arange(blk)[:, None]
    ki = jnp.arange(2 * blk)[None, :]
    dist = blk + qi - ki
    band = (dist >= 0) & (dist <= blk)
    has_prev = (jnp.arange(nb) > 0)[:, None, None] | (ki >= blk)[None]
    mask = band[None] & has_prev
    s = jnp.where(mask[None, None, :, None], s, -jnp.inf)
    lse = jax.nn.logsumexp(s, axis=-1)
    p = jnp.exp(s - lse[..., None])
    o = jnp.einsum('brnhqk,brnkhd->brnqhd', p.astype(v.dtype), vc)
    o = o.reshape(B, dilation, L, H, Dh).transpose(0, 2, 1, 3, 4).reshape(B, s_pad, H, Dh)[:, :S]
    lse = lse.transpose(0, 1, 2, 4, 3).reshape(B, dilation, L, H).transpose(0, 2, 1, 3).reshape(B, s_pad, H)[:, :S]
    return o, lse


def gla_chunked(q, k, v, log_g):
    B, S, H, DK = q.shape
    DV = v.shape[-1]
    nc = S // GLA_CHUNK

    def chunks(t):
        return t.reshape(B, nc, GLA_CHUNK, H, t.shape[-1]).transpose(1, 0, 3, 2, 4)

    causal = jnp.tril(jnp.ones((GLA_CHUNK, GLA_CHUNK), dtype=bool))

    def step(state, inp):
        qc, kc, vc, gc = inp
        bcum = jnp.cumsum(gc.astype(jnp.float32), axis=2)
        o_inter = jnp.einsum('bhtk,bhkv->bhtv', qc * jnp.exp(bcum), state)
        rel = bcum[:, :, :, None, :] - bcum[:, :, None, :, :]
        dec = jnp.exp(jnp.where(causal[:, :, None], rel, -jnp.inf))
        att = jnp.einsum('bhtk,bhsk,bhtsk->bhts', qc, kc, dec)
        o_intra = jnp.einsum('bhts,bhsv->bhtv', att, vc)
        b_last = bcum[:, :, -1:, :]
        state = state * jnp.exp(b_last)[:, :, 0, :, None] + jnp.einsum('bhsk,bhsv->bhkv', kc * jnp.exp(b_last - bcum), vc)
        return state, o_inter + o_intra

    _, o = lax.scan(step, jnp.zeros((B, H, DK, DV), jnp.float32), (chunks(q), chunks(k), chunks(v), chunks(log_g)))
    return o.transpose(1, 0, 3, 2, 4).reshape(B, S, H, DV).astype(v.dtype)


def mla_rwkv_mixer(h, positions, w_in, q_norm, w_uq, kv_norm, w_ukv, q_head_norm, k_head_norm,
                   mu, w0, w2, a0, a2, g2, k_k, k_a, r_k, ln_w, ln_b, w_out):
    B, S, _ = h.shape
    p = h @ w_in
    c_q, c_kv, k_r, p_rwkv = split_cols(p, MLA_COLS + (RWKV_IN,))
    q = (rmsnorm(c_q, q_norm) @ w_uq).reshape(B, S, MLA_HEADS, MLA_QK_DIM)
    kv = (rmsnorm(c_kv, kv_norm) @ w_ukv).reshape(B, S, MLA_HEADS, MLA_NOPE_DIM + MLA_V_DIM)
    k_nope, v_a = kv[..., :MLA_NOPE_DIM], kv[..., MLA_NOPE_DIM:]
    k_rope = jnp.broadcast_to(k_r[:, :, None, :], (B, S, MLA_HEADS, MLA_ROPE_DIM))
    q = rmsnorm(q, q_head_norm)
    k = rmsnorm(jnp.concatenate([k_nope, k_rope], axis=-1), k_head_norm)
    q = jnp.concatenate([q[..., :MLA_NOPE_DIM], rope(q[..., MLA_NOPE_DIM:], positions)], axis=-1)
    k = jnp.concatenate([k[..., :MLA_NOPE_DIM], rope(k[..., MLA_NOPE_DIM:], positions)], axis=-1)
    o_a = causal_blocked_attention(q, k, v_a, MLA_QK_DIM ** -0.5).reshape(B, S, -1)
    xs = p_rwkv + (token_shift(p_rwkv) - p_rwkv) * mu
    r, k_b, v_b, xw, xa, xg = split_cols(xs, RWKV_COLS)
    w = -jax.nn.softplus(-(w0 + jnp.tanh(xw) @ w2)) - 0.5
    decay = jnp.exp(-jnp.exp(w.astype(jnp.float32)))
    a = jax.nn.sigmoid(a0 + xa @ a2)
    g = jax.nn.sigmoid(xg) @ g2

    def heads(t):
        return t.reshape(B, S, RWKV_HEADS, RWKV_HEAD)

    kk = heads(k_b * k_k)
    kk = kk / jnp.maximum(jnp.linalg.norm(kk, axis=-1, keepdims=True), 1e-12)
    k_h = heads(k_b * (1.0 + (a - 1.0) * k_a))
    r_h, v_h, a_h = heads(r), heads(v_b), heads(a)
    y = rwkv7_recurrence(r_h, heads(decay), k_h, v_h, -kk, kk * a_h)
    y = head_groupnorm(y, ln_w, ln_b, RWKV_GN_EPS)
    bonus = (jnp.sum(r_h * k_h * r_k, axis=-1, keepdims=True) * v_h).reshape(B, S, -1)
    o_b = (y + bonus) * g
    return jnp.concatenate([o_a, o_b], axis=-1) @ w_out


def swa_gla_mixer(h, positions, w_in, q_head_norm, k_head_norm, w_gate_up, b_gate, gla_norm, w_out):
    B, S, _ = h.shape
    p = h @ w_in
    q_c, k_c, v_c, q_d, k_d, v_d, g_lr, r_d = split_cols(p, SWA_COLS + GLA_COLS)
    def sh(t):
        return t.reshape(B, S, SWA_HEADS, SWA_HEAD_DIM)

    q_c = rope(rmsnorm(sh(q_c), q_head_norm), positions)
    k_c = rope(rmsnorm(sh(k_c), k_head_norm), positions)
    v_c = sh(v_c)
    outs, lses = [], []
    for window, dilation in SWA_PATTERNS:
        o_i, lse_i = dilated_window_attention(q_c, k_c, v_c, window, dilation)
        outs.append(o_i)
        lses.append(lse_i)
    wts = jax.nn.softmax(jnp.stack(lses, axis=0), axis=0)
    o_c = jnp.sum(wts[..., None] * jnp.stack(outs, axis=0).astype(jnp.float32), axis=0).astype(h.dtype).reshape(B, S, -1)
    def gh(t, n):
        return t.reshape(B, S, GLA_HEADS, n)

    log_g = jax.nn.log_sigmoid((g_lr @ w_gate_up + b_gate).astype(jnp.float32)) / GLA_GATE_NORMALIZER
    o_d = gla_chunked(gh(q_d, GLA_DK) * GLA_DK ** -0.5, gh(k_d, GLA_DK), gh(v_d, GLA_DV), gh(log_g, GLA_DK))
    o_d = rmsnorm(o_d, gla_norm).reshape(B, S, -1) * jax.nn.silu(r_d)
    return jnp.concatenate([o_c, o_d], axis=-1) @ w_out


def setup_inputs(seed: int = 0) -> dict:
    key = jax.random.key(seed)
    ks = iter(jax.random.split(key, 40))

    def dense(shape):
        return jax.random.normal(next(ks), shape, jnp.float32) * shape[-2] ** -0.5

    def around(shape, center, s):
        return center + s * jax.random.normal(next(ks), shape, jnp.float32)

    def unif(shape, lo, hi):
        return jax.random.uniform(next(ks), shape, jnp.float32, lo, hi)

    return {
        'x': jax.random.normal(next(ks), (BATCH, SEQ, D_MODEL), jnp.float32),
        'positions': jnp.broadcast_to(jnp.arange(SEQ, dtype=jnp.int32)[None, :], (BATCH, SEQ)),
        'ffn_norm': around((DEPTH, 2, D_MODEL), 1.0, 0.02),
        'ffn_w_gate': dense((DEPTH, 2, D_MODEL, D_FF)),
        'ffn_w_up': dense((DEPTH, 2, D_MODEL, D_FF)),
        'ffn_w_down': dense((DEPTH, 2, D_FF, D_MODEL)),
        'mix_norm': around((DEPTH, D_MODEL), 1.0, 0.02),
        'mla_rwkv_w_in': dense((N_EVEN, D_MODEL, EVEN_IN)),
        'mla_q_norm': around((N_EVEN, MLA_Q_LORA), 1.0, 0.02),
        'mla_w_uq': dense((N_EVEN, MLA_Q_LORA, MLA_HEADS * MLA_QK_DIM)),
        'mla_kv_norm': around((N_EVEN, MLA_KV_LORA), 1.0, 0.02),
        'mla_w_ukv': dense((N_EVEN, MLA_KV_LORA, MLA_HEADS * (MLA_NOPE_DIM + MLA_V_DIM))),
        'mla_q_head_norm': around((N_EVEN, MLA_QK_DIM), 1.0, 0.02),
        'mla_k_head_norm': around((N_EVEN, MLA_QK_DIM), 1.0, 0.02),
        'rwkv_mu': unif((N_EVEN, RWKV_IN), 0.0, 1.0),
        'rwkv_w0': unif((N_EVEN, RWKV_WIDTH), -6.0, 1.0),
        'rwkv_w2': dense((N_EVEN, RWKV_W_LORA, RWKV_WIDTH)),
        'rwkv_a0': around((N_EVEN, RWKV_WIDTH), 0.0, 0.5),
        'rwkv_a2': dense((N_EVEN, RWKV_A_LORA, RWKV_WIDTH)),
        'rwkv_g2': dense((N_EVEN, RWKV_G_LORA, RWKV_WIDTH)),
        'rwkv_k_k': around((N_EVEN, RWKV_WIDTH), 0.85, 0.05),
        'rwkv_k_a': around((N_EVEN, RWKV_WIDTH), 1.0, 0.05),
        'rwkv_r_k': around((N_EVEN, RWKV_HEADS, RWKV_HEAD), 0.0, 0.1),
        'rwkv_ln_w': around((N_EVEN, RWKV_WIDTH), 1.0, 0.02),
        'rwkv_ln_b': around((N_EVEN, RWKV_WIDTH), 0.0, 0.02),
        'mla_rwkv_w_out': dense((N_EVEN, D_MIX, D_MODEL)),
        'swa_gla_w_in': dense((N_ODD, D_MODEL, ODD_IN)),
        'swa_q_head_norm': around((N_ODD, SWA_HEAD_DIM), 1.0, 0.02),
        'swa_k_head_norm': around((N_ODD, SWA_HEAD_DIM), 1.0, 0.02),
        'gla_w_gate_up': dense((N_ODD, GLA_GATE_LORA, GLA_HEADS * GLA_DK)),
        'gla_b_gate': around((N_ODD, GLA_HEADS * GLA_DK), 0.0, 0.1),
        'gla_norm': around((N_ODD, GLA_HEADS, GLA_DV), 1.0, 0.02),
        'swa_gla_w_out': dense((N_ODD, D_MIX, D_MODEL)),
    }


def reference(x, positions, ffn_norm, ffn_w_gate, ffn_w_up, ffn_w_down, mix_norm,
              mla_rwkv_w_in, mla_q_norm, mla_w_uq, mla_kv_norm, mla_w_ukv, mla_q_head_norm, mla_k_head_norm,
              rwkv_mu, rwkv_w0, rwkv_w2, rwkv_a0, rwkv_a2, rwkv_g2, rwkv_k_k, rwkv_k_a, rwkv_r_k,
              rwkv_ln_w, rwkv_ln_b, mla_rwkv_w_out,
              swa_gla_w_in, swa_q_head_norm, swa_k_head_norm, gla_w_gate_up, gla_b_gate, gla_norm, swa_gla_w_out):
    h = x
    for layer in range(DEPTH):
        i = layer // 2
        h = h + MACARON_WEIGHT * swiglu(rmsnorm(h, ffn_norm[layer, 0]), ffn_w_gate[layer, 0], ffn_w_up[layer, 0], ffn_w_down[layer, 0])
        hn = rmsnorm(h, mix_norm[layer])
        if layer % 2 == 0:
            h = h + mla_rwkv_mixer(hn, positions, mla_rwkv_w_in[i], mla_q_norm[i], mla_w_uq[i], mla_kv_norm[i],
                                   mla_w_ukv[i], mla_q_head_norm[i], mla_k_head_norm[i],
                                   rwkv_mu[i], rwkv_w0[i], rwkv_w2[i], rwkv_a0[i], rwkv_a2[i], rwkv_g2[i],
                                   rwkv_k_k[i], rwkv_k_a[i], rwkv_r_k[i], rwkv_ln_w[i], rwkv_ln_b[i], mla_rwkv_w_out[i])
        else:
            h = h + swa_gla_mixer(hn, positions, swa_gla_w_in[i], swa_q_head_norm[i], swa_k_head_norm[i],
                                  gla_w_gate_up[i], gla_b_gate[i], gla_norm[i], swa_gla_w_out[i])
        h = h + MACARON_WEIGHT * swiglu(rmsnorm(h, ffn_norm[layer, 1]), ffn_w_gate[layer, 1], ffn_w_up[layer, 1], ffn_w_down[layer, 1])
    return h
```

```cpp
#include <hip/hip_runtime.h>
#include <hip/hip_cooperative_groups.h>
#include <cstdio>
#include <cstring>
namespace cg = cooperative_groups;
#ifndef PROBE
#define PROBE 0
#endif
#ifndef PHMASK
#define PHMASK 0xFFFF
#endif

#define LAS __attribute__((address_space(3)))
#define DEVI __device__ __forceinline__
typedef unsigned short bf16_t;
typedef short bf16x8 __attribute__((ext_vector_type(8)));
typedef short s16x4 __attribute__((ext_vector_type(4)));
typedef float f32x4 __attribute__((ext_vector_type(4)));
typedef float f32x2 __attribute__((ext_vector_type(2)));
typedef float f32x16 __attribute__((ext_vector_type(16)));
typedef unsigned u32x4 __attribute__((ext_vector_type(4)));
typedef unsigned u32x2 __attribute__((ext_vector_type(2)));

constexpr int S = 16384, DM = 2048, DFF = 5632;
constexpr int EVEN_LD = 4352, ODD_LD = 6400;
constexpr int NT = 512;
constexpr int LDS_BYTES = 147456;

constexpr size_t SZ = (size_t)S;
constexpr size_t OFF_CNT = 0;
constexpr size_t OFF_RS = 1024;
constexpr size_t OFF_BAR = OFF_RS + 64 * SZ * 4;
constexpr size_t OFF_WINE = OFF_BAR + 16384;
constexpr size_t OFF_WUQ = OFF_WINE + (size_t)EVEN_LD * 2048 * 2;
constexpr size_t OFF_WUKV = OFF_WUQ + (size_t)1536 * 512 * 2;
constexpr size_t OFF_LORA = OFF_WUKV + (size_t)2048 * 256 * 2;
constexpr size_t OFF_WOUTE = OFF_LORA + (size_t)3072 * 384 * 2;
constexpr size_t OFF_WINO = OFF_WOUTE + (size_t)2048 * 2048 * 2;
constexpr size_t OFF_WOUTO = OFF_WINO + (size_t)ODD_LD * 2048 * 2;
constexpr size_t OFF_ROPE64 = OFF_WOUTO + (size_t)2048 * 2048 * 2;
constexpr size_t OFF_ROPE128 = OFF_ROPE64 + SZ * 64 * 4;
constexpr size_t OFF_GUT = OFF_ROPE128 + SZ * 128 * 4;
constexpr size_t OFF_DT = OFF_GUT + (size_t)11264 * 2048 * 2;
constexpr size_t OFF_XN = OFF_DT + (size_t)2048 * 5632 * 2;
constexpr size_t OFF_BIG = OFF_XN + SZ * 2048 * 2;
constexpr size_t OFF_HB = OFF_BIG;
constexpr size_t OFF_HID = OFF_BIG + SZ * 2048 * 2;
constexpr size_t E_P = OFF_BIG;
constexpr size_t E_R = E_P + SZ * EVEN_LD * 2;
constexpr size_t E_KB = E_R + SZ * 1024 * 2;
constexpr size_t E_V = E_KB + SZ * 1024 * 2;
constexpr size_t E_CQN = E_V + SZ * 1024 * 2;
constexpr size_t E_CKVN = E_CQN + SZ * 512 * 2;
constexpr size_t E_LIN = E_CKVN + SZ * 256 * 2;
constexpr size_t E_KR = E_LIN + SZ * 384 * 2;
constexpr size_t E_Q = E_KR + SZ * 64 * 2;
constexpr size_t E_KV = E_Q + SZ * 1536 * 2;
constexpr size_t E_K = E_KV + SZ * 2048 * 2;
constexpr size_t E_LOUT = E_K + SZ * 1536 * 2;
constexpr size_t E_SIN = E_LOUT + SZ * 3072 * 2;
constexpr size_t E_END = E_SIN + (size_t)16 * 64 * 4096 * 4;
constexpr size_t E_PU = E_KB;
constexpr size_t E_DECAY = E_P;
constexpr size_t E_KH = E_P + SZ * 1024 * 4;
constexpr size_t E_NA = E_KH + SZ * 1024 * 2;
constexpr size_t E_BB = E_CQN;
constexpr size_t E_Y = E_KB;
constexpr size_t O_P = OFF_BIG;
constexpr size_t O_LG = O_P + SZ * ODD_LD * 2;
constexpr size_t O_UST = O_LG + SZ * 512 * 4;
constexpr size_t O_DVEC = O_UST + (size_t)256 * 4 * 128 * 256 * 4;
constexpr size_t O_OPAT = O_DVEC + (size_t)256 * 4 * 128 * 4;
constexpr size_t O_LSE = O_OPAT + 3 * SZ * 1024 * 2;
constexpr size_t O_END = O_LSE + 3 * SZ * 8 * 4;
constexpr size_t FFN_END = OFF_HID + SZ * 5632 * 2;
constexpr size_t WS_NEED = (E_END > O_END ? (E_END > FFN_END ? E_END : FFN_END) : (O_END > FFN_END ? O_END : FFN_END));

DEVI int otid() { int t = __builtin_amdgcn_workitem_id_x(); asm volatile("" : "+v"(t)); return t; }
DEVI int obid() { int b = __builtin_amdgcn_workgroup_id_x(); asm volatile("" : "+s"(b)); return b; }
DEVI unsigned pk_bf16(float lo, float hi) { unsigned r; asm("v_cvt_pk_bf16_f32 %0, %1, %2" : "=v"(r) : "v"(lo), "v"(hi)); return r; }
DEVI float bf_lo(unsigned u) { return __uint_as_float(u << 16); }
DEVI float bf_hi(unsigned u) { return __uint_as_float(u & 0xffff0000u); }
DEVI float bf2f(bf16_t b) { return __uint_as_float(((unsigned)b) << 16); }
DEVI bf16_t f2bf(float f) { return (bf16_t)(pk_bf16(f, 0.f) & 0xffffu); }
DEVI unsigned xb_xcc_id() { return (unsigned)__builtin_amdgcn_s_getreg((3 << 11) | 20) & 0xFu; }
DEVI float wave_sum(float v) {
#pragma unroll
    for (int o = 32; o > 0; o >>= 1) v += __shfl_xor(v, o);
    return v;
}
DEVI float sum_xor16_32(float v) {
    u32x2 a = __builtin_amdgcn_permlane16_swap(__float_as_uint(v), __float_as_uint(v), false, false);
    v = __uint_as_float(a[0]) + __uint_as_float(a[1]);
    a = __builtin_amdgcn_permlane32_swap(__float_as_uint(v), __float_as_uint(v), false, false);
    return __uint_as_float(a[0]) + __uint_as_float(a[1]);
}
DEVI float sigmoidf_(float x) { return __builtin_amdgcn_rcpf(1.0f + __expf(-x)); }
DEVI float siluf_(float x) { return x * __builtin_amdgcn_rcpf(1.0f + __expf(-x)); }
DEVI void unpack8(u32x4 u, float* f) {
    f[0] = bf_lo(u.x); f[1] = bf_hi(u.x); f[2] = bf_lo(u.y); f[3] = bf_hi(u.y);
    f[4] = bf_lo(u.z); f[5] = bf_hi(u.z); f[6] = bf_lo(u.w); f[7] = bf_hi(u.w);
}
DEVI u32x4 pack8(const float* f) { u32x4 u; u.x = pk_bf16(f[0], f[1]); u.y = pk_bf16(f[2], f[3]); u.z = pk_bf16(f[4], f[5]); u.w = pk_bf16(f[6], f[7]); return u; }

struct GemmDesc { const bf16_t* A; const bf16_t* Bt; void* out; const float* res; const float* rs_in; float* rs_out; bf16_t* hb_out; int lda, ldb, ldc, N, K, epi; float scale; int rs_n; };
struct Step { int kind, a0, a1, a2, sync, p0, p1, p2; };
enum { K_INIT = 0, K_NORM, K_GEMM, K_EPREP1, K_EPREP2, K_EMIX, K_EPOST, K_OPREP, K_OATTN, K_GSCAN, K_OFINAL };
struct Params {
    const float* in[33];
    float* out;
    unsigned char* ws;
    GemmDesc gd[16];
    Step st[32];
    int nsteps, pad;
};

namespace pg8 {
constexpr int BM = 256, BK = 64, HALF = 128, HTB = HALF * BK * 2, STAGE_BYTES = 8 * HTB, NXCD = 8, WGM = 8;
DEVI int lds_byte(int r, int c) { const int st = (r >> 4) * 2 + (c >> 5), rr = r & 15, cc = c & 31, ob = rr * 64 + cc * 2; return st * 1024 + (ob ^ (((ob >> 9) & 1) << 5)); }
DEVI void stage_rc(int b, int& R, int& C) { const int st = b / 1024, sb = b % 1024, swz = sb ^ (((sb >> 9) & 1) << 5); R = (st >> 1) * 16 + swz / 64; C = (st & 1) * 32 + (swz % 64) / 2; }
DEVI int perm32(int rho) { const int n = rho >> 4, i = rho & 15; return 8 * (i >> 2) + 4 * n + (i & 3); }
struct Unit { int pm, pn; };
struct StaticOrder {
    int nM, nN, nwg, G, c;
    DEVI void init(int M, int N, int G_, int c_) { nM = M / BM; nN = N / BM; nwg = nM * nN; G = G_; c = c_; }
    DEVI bool next(int i, Unit& u) const {
        const long L = (long)i * G + c; if (L >= nwg) return false;
        int wgid = (int)L; { const int q = nwg / NXCD, r = nwg % NXCD, xcd = wgid % NXCD, off = wgid / NXCD; wgid = (xcd < r ? xcd * (q + 1) : r * (q + 1) + (xcd - r) * q) + off; }
        const int nig = WGM * nN, gid = wgid / nig, fm = gid * WGM, gsz = (nM - fm) < WGM ? (nM - fm) : WGM;
        u.pm = fm + ((wgid % nig) % gsz); u.pn = (wgid % nig) / gsz; return true;
    }
};
DEVI float row_rstd(const LAS float* rsl, int r) { return rsqrtf((rsl[r] + rsl[256 + r]) * (1.0f / DM) + 1e-6f); }
struct EpiBf16 {
    static constexpr bool PERM = true, HAS_RS = true;
    bf16_t* O_; int ldc_; const float* rs_; int rsn_;
    DEVI void operator()(const f32x4 (&acc)[2][2][4][2], const Unit& u, int wr, int wc, int fr, int fq, const LAS float* rsl) const {
        bf16_t* const O = O_; const int ldc = ldc_; const float* const rs = rs_; const int rsn = rsn_;
        const int row0 = u.pm * BM + wr * 64 + fr, col0 = u.pn * BM + wc * 32 + 8 * fq;
#pragma unroll
        for (int ai = 0; ai < 2; ++ai)
#pragma unroll
            for (int m = 0; m < 4; ++m) { bf16_t* rowp = O + (size_t)(row0 + ai * HALF + m * 16) * ldc + col0;
                const float sc = rs ? row_rstd(rsl, wr * 64 + fr + ai * HALF + m * 16) : 1.0f;
#pragma unroll
                for (int bj = 0; bj < 2; ++bj) { const f32x4 v0 = acc[ai][bj][m][0] * sc, v1 = acc[ai][bj][m][1] * sc;
                    u32x4 w; w.x = pk_bf16(v0[0], v0[1]); w.y = pk_bf16(v0[2], v0[3]); w.z = pk_bf16(v1[0], v1[1]); w.w = pk_bf16(v1[2], v1[3]);
                    *(u32x4*)(rowp + bj * HALF) = w; } }
    }
};
struct EpiSwiglu {
    static constexpr bool PERM = true, HAS_RS = true;
    bf16_t* O_; int ldc_; const float* rs_; int rsn_;
    DEVI void operator()(const f32x4 (&acc)[2][2][4][2], const Unit& u, int wr, int wc, int fr, int fq, const LAS float* rsl) const {
        bf16_t* const O = O_; const int ldc = ldc_; const float* const rs = rs_; const int rsn = rsn_;
        const int row0 = u.pm * BM + wr * 64 + fr, col0 = u.pn * HALF + wc * 32 + 8 * fq;
#pragma unroll
        for (int ai = 0; ai < 2; ++ai)
#pragma unroll
            for (int m = 0; m < 4; ++m) { bf16_t* rowp = O + (size_t)(row0 + ai * HALF + m * 16) * ldc + col0;
                const float sc = row_rstd(rsl, wr * 64 + fr + ai * HALF + m * 16);
                const float k1 = -1.4426950408889634f * sc, k2 = sc * sc;
                float h[8], tt[8];
                const f32x4 guk0 = (acc[ai][0][m][0] * acc[ai][1][m][0]) * k2, guk1 = (acc[ai][0][m][1] * acc[ai][1][m][1]) * k2;
                const f32x4 ta = acc[ai][0][m][0] * k1, tb = acc[ai][0][m][1] * k1;
#pragma unroll
                for (int j = 0; j < 4; ++j) { tt[j] = __builtin_amdgcn_exp2f(ta[j]); tt[4 + j] = __builtin_amdgcn_exp2f(tb[j]); }
                __builtin_amdgcn_sched_barrier(0);
#pragma unroll
                for (int j = 0; j < 8; ++j) tt[j] = __builtin_amdgcn_rcpf(1.0f + tt[j]);
                __builtin_amdgcn_sched_barrier(0);
#pragma unroll
                for (int j = 0; j < 4; ++j) { h[j] = guk0[j] * tt[j]; h[4 + j] = guk1[j] * tt[4 + j]; }
                *(u32x4*)rowp = pack8(h); }
    }
};
struct EpiResid {
    static constexpr bool PERM = false, HAS_RS = false;
    float* C_; const float* R_; int ldc_; float scale_; bf16_t* HB_; float* RS_;
    DEVI void operator()(const f32x4 (&acc)[2][2][4][2], const Unit& u, int wr, int wc, int fr, int fq, const LAS float*) const {
        float* const C = C_; const float* const R = R_; const int ldc = ldc_; bf16_t* const HB = HB_; float* const RS = RS_;
        float scale = scale_; asm volatile("" : "+v"(scale));
        const int row0 = u.pm * BM + wr * 64 + fr, col0 = u.pn * BM + wc * 32 + 4 * fq;
        f32x4 cur[2][2], nxt[2][2];
        { const size_t ro = (size_t)row0 * ldc + col0;
#pragma unroll
          for (int bj = 0; bj < 2; ++bj)
#pragma unroll
              for (int n = 0; n < 2; ++n) cur[bj][n] = *(const f32x4*)(R + ro + bj * HALF + n * 16); }
#pragma unroll
        for (int idx = 0; idx < 8; ++idx) {
            const int ai = idx >> 2, m = idx & 3;
            const size_t ro = (size_t)(row0 + ai * HALF + m * 16) * ldc + col0;
            if (idx + 1 < 8) { const int ai2 = (idx + 1) >> 2, m2 = (idx + 1) & 3; const size_t ro2 = (size_t)(row0 + ai2 * HALF + m2 * 16) * ldc + col0;
#pragma unroll
                for (int bj = 0; bj < 2; ++bj)
#pragma unroll
                    for (int n = 0; n < 2; ++n) nxt[bj][n] = *(const f32x4*)(R + ro2 + bj * HALF + n * 16); }
            float ss = 0.f;
#pragma unroll
            for (int bj = 0; bj < 2; ++bj)
#pragma unroll
                for (int n = 0; n < 2; ++n) {
                    const f32x4 hn = cur[bj][n] + acc[ai][bj][m][n] * scale;
                    *(f32x4*)(C + ro + bj * HALF + n * 16) = hn;
                    if (HB) { u32x2 w; w.x = pk_bf16(hn[0], hn[1]); w.y = pk_bf16(hn[2], hn[3]); *(u32x2*)(HB + ro + bj * HALF + n * 16) = w;
                        ss += hn[0] * hn[0] + hn[1] * hn[1] + hn[2] * hn[2] + hn[3] * hn[3]; } }
            if (HB) { ss = sum_xor16_32(ss); if (fq == 0) RS[(size_t)(row0 + ai * HALF + m * 16) * 32 + u.pn * 4 + wc] = ss; }
#pragma unroll
            for (int bj = 0; bj < 2; ++bj)
#pragma unroll
                for (int n = 0; n < 2; ++n) cur[bj][n] = nxt[bj][n];
        }
    }
};

template <class Epi>
DEVI void gemm_phase(LAS unsigned char* lds, const bf16_t* gA, const bf16_t* gBt, const int lda, const int ldb, const int K, const StaticOrder S_, const Epi E) {
    const int tid = otid(), wid = __builtin_amdgcn_readfirstlane(tid >> 6), lane = tid & 63, wr = wid >> 2, wc = wid & 3, fr = lane & 15, fq = lane >> 4;
    const int nt = K / BK;
    unsigned voffA[2], voffB[2];
#pragma unroll
    for (int i = 0; i < 2; ++i) { int R, C; stage_rc(tid * 16 + i * 8192, R, C); const int Rb = Epi::PERM ? ((R & ~31) + perm32(R & 31)) : R;
        voffA[i] = (unsigned)(R * lda + C) * 2u; voffB[i] = (unsigned)(Rb * ldb + C) * 2u; }
    const size_t kstep = (size_t)(BK * 2);
    const size_t hstepA = (size_t)HALF * lda * 2, hstepB = (size_t)HALF * ldb * 2;
    const size_t tstepA = 2 * hstepA, tstepB = 2 * hstepB;
    const unsigned ldsw = (unsigned)wid * 1024u;
    const int aoff = lds_byte(wr * 64 + fr, fq * 8), boff = lds_byte(wc * 32 + fr, fq * 8);
#define PG8_SA(b, h) (((b) * 2 + (h)) * HTB)
#define PG8_SB(b, h) ((4 + (b) * 2 + (h)) * HTB)
#define PG8_STAGE(bufoff, gbase, voff) do { _Pragma("unroll") for (int _i = 0; _i < 2; ++_i) \
        __builtin_amdgcn_global_load_lds((const unsigned*)((const char*)(gbase) + (voff)[_i]), (LAS unsigned*)(lds + (bufoff) + ldsw + _i * 8192), 16, 0, 0); } while (0)
#define PG8_LDA(dst, b, h) do { _Pragma("unroll") for (int m = 0; m < 4; ++m) _Pragma("unroll") for (int k = 0; k < 2; ++k) dst[m][k] = *(const LAS bf16x8*)(lds + PG8_SA(b, h) + aoff + m * 2048 + k * 1024); } while (0)
#define PG8_LDB(dst, b, h) do { _Pragma("unroll") for (int n = 0; n < 2; ++n) _Pragma("unroll") for (int k = 0; k < 2; ++k) dst[n][k] = *(const LAS bf16x8*)(lds + PG8_SB(b, h) + boff + n * 2048 + k * 1024); } while (0)
#define PG8_MMA(ai, bj, At, Bt) do { __builtin_amdgcn_s_setprio(1); _Pragma("unroll") for (int m = 0; m < 4; ++m) _Pragma("unroll") for (int n = 0; n < 2; ++n) _Pragma("unroll") for (int k = 0; k < 2; ++k) \
        acc[ai][bj][m][n] = __builtin_amdgcn_mfma_f32_16x16x32_bf16(Bt[n][k], At[m][k], acc[ai][bj][m][n], 0, 0, 0); __builtin_amdgcn_s_setprio(0); } while (0)
#define PG8_WAIT_V(n) asm volatile("s_waitcnt vmcnt(" #n ")" ::: "memory")
#define PG8_WAIT_L(n) asm volatile("s_waitcnt lgkmcnt(" #n ")" ::: "memory")
#define PG8_BAR __builtin_amdgcn_s_barrier()
#define PG8_SCHED __builtin_amdgcn_sched_barrier(0)
    Unit cur, nxt; int ui = 0;
    if (!S_.next(0, cur)) return;
    auto rs_prefetch = [&](const Unit& u, int par) {
        if constexpr (Epi::HAS_RS) { if (E.rs_) {
            const int r = tid & 255, hf = tid >> 8; float s = 0.f;
            const float* base = E.rs_ + (size_t)(u.pm * BM + r) * 32 + hf * 16;
            if (E.rsn_ == 32) {
                const f32x4 a = *(const f32x4*)base, b = *(const f32x4*)(base + 4), c = *(const f32x4*)(base + 8), d = *(const f32x4*)(base + 12);
                s = ((a[0] + a[1]) + (a[2] + a[3])) + ((b[0] + b[1]) + (b[2] + b[3])) + ((c[0] + c[1]) + (c[2] + c[3])) + ((d[0] + d[1]) + (d[2] + d[3]));
            } else if (hf == 0) s = base[0];
            *(LAS float*)(lds + STAGE_BYTES + par * 2048 + hf * 1024 + r * 4) = s; } }
    };
    f32x4 acc[2][2][4][2];
#pragma unroll
    for (int a = 0; a < 2; ++a)
#pragma unroll
        for (int b = 0; b < 2; ++b)
#pragma unroll
            for (int m = 0; m < 4; ++m)
#pragma unroll
                for (int n = 0; n < 2; ++n) acc[a][b][m][n] = (f32x4){0.f, 0.f, 0.f, 0.f};
    bf16x8 At[4][2], B0[2][2], B1[2][2];
    const char* cA = (const char*)gA + (size_t)cur.pm * tstepA; const char* cB = (const char*)gBt + (size_t)cur.pn * tstepB;
    PG8_STAGE(PG8_SB(0, 0), cB, voffB); PG8_STAGE(PG8_SA(0, 0), cA, voffA); PG8_STAGE(PG8_SB(0, 1), cB + hstepB, voffB); PG8_STAGE(PG8_SA(0, 1), cA + hstepA, voffA);
    if (wr == 1) PG8_BAR;
    PG8_WAIT_V(4); PG8_BAR;
    PG8_STAGE(PG8_SB(1, 0), cB + kstep, voffB); PG8_STAGE(PG8_SA(1, 0), cA + kstep, voffA); PG8_STAGE(PG8_SB(1, 1), cB + hstepB + kstep, voffB);
    PG8_WAIT_V(6); PG8_BAR;
    rs_prefetch(cur, 0);
    for (;;) {
        const bool has_next = S_.next(ui + 1, nxt);
        const char* nA = has_next ? (const char*)gA + (size_t)nxt.pm * tstepA : cA; const char* nB = has_next ? (const char*)gBt + (size_t)nxt.pn * tstepB : cB;
        for (int t = 0; t < nt; t += 2) {
            const bool last = (t == nt - 2);
            const char* a1 = cA + (size_t)(t + 1) * kstep;
            const char* a2 = last ? nA : cA + (size_t)(t + 2) * kstep; const char* b2 = last ? nB : cB + (size_t)(t + 2) * kstep;
            const char* a3 = a2 + kstep; const char* b3 = b2 + kstep;
            PG8_LDB(B0, 0, 0); PG8_SCHED; PG8_LDA(At, 0, 0); PG8_STAGE(PG8_SA(1, 1), a1 + hstepA, voffA);
            PG8_WAIT_L(8); PG8_BAR; PG8_WAIT_L(0); PG8_MMA(0, 0, At, B0); PG8_BAR; PG8_SCHED;
            PG8_LDB(B1, 0, 1); PG8_STAGE(PG8_SB(0, 0), b2, voffB);
            PG8_BAR; PG8_WAIT_L(0); PG8_MMA(0, 1, At, B1); PG8_BAR;
            PG8_LDA(At, 0, 1); PG8_STAGE(PG8_SA(0, 0), a2, voffA);
            PG8_BAR; PG8_WAIT_L(0); PG8_MMA(1, 0, At, B0); PG8_BAR; PG8_SCHED;
            PG8_STAGE(PG8_SB(0, 1), b2 + hstepB, voffB);
            PG8_WAIT_V(6); PG8_BAR; PG8_MMA(1, 1, At, B1); PG8_BAR;
            PG8_LDB(B0, 1, 0); PG8_SCHED; PG8_LDA(At, 1, 0); PG8_STAGE(PG8_SA(0, 1), a2 + hstepA, voffA);
            PG8_WAIT_L(8); PG8_BAR; PG8_WAIT_L(0); PG8_MMA(0, 0, At, B0); PG8_BAR; PG8_SCHED;
            PG8_LDB(B1, 1, 1); PG8_STAGE(PG8_SB(1, 0), b3, voffB);
            PG8_BAR; PG8_WAIT_L(0); PG8_MMA(0, 1, At, B1); PG8_BAR;
            PG8_LDA(At, 1, 1); PG8_STAGE(PG8_SA(1, 0), a3, voffA);
            PG8_BAR; PG8_WAIT_L(0); PG8_MMA(1, 0, At, B0); PG8_BAR; PG8_SCHED;
            PG8_STAGE(PG8_SB(1, 1), b3 + hstepB, voffB);
            PG8_WAIT_V(6); PG8_BAR; PG8_MMA(1, 1, At, B1); PG8_BAR;
        }
        E(acc, cur, wr, wc, fr, fq, (const LAS float*)(lds + STAGE_BYTES + (ui & 1) * 2048));
        if (!has_next) break;
#pragma unroll
        for (int a = 0; a < 2; ++a)
#pragma unroll
            for (int b = 0; b < 2; ++b)
#pragma unroll
                for (int m = 0; m < 4; ++m)
#pragma unroll
                    for (int n = 0; n < 2; ++n) acc[a][b][m][n] = (f32x4){0.f, 0.f, 0.f, 0.f};
        cur = nxt; cA = nA; cB = nB; ++ui;
        rs_prefetch(cur, ui & 1);
    }
    PG8_WAIT_V(0);
    if (wr == 0) PG8_BAR;
    PG8_BAR;
#undef PG8_SA
#undef PG8_SB
#undef PG8_STAGE
#undef PG8_LDA
#undef PG8_LDB
#undef PG8_MMA
#undef PG8_WAIT_V
#undef PG8_WAIT_L
#undef PG8_BAR
#undef PG8_SCHED
}
}

DEVI void cvt_job(LAS float* tile, const float* src, int srcK, int srcN, bf16_t* dst, int dstLd, int dstRows, int dstCol0, int mode, const float* gk = nullptr) {
    const int tid = otid(), ntc = dstLd >> 7, nvr = mode ? (dstRows >> 7) : (dstRows >> 6), ntot = nvr * ntc;
    const int tx = tid & 63, ty = tid >> 6;
    float regsA[16], regsB[16];
    auto coords = [&](int t, int& rho0, int& kap0, int& n0) {
        const int tc = t / nvr, v = t - tc * nvr; kap0 = tc << 7;
        if (mode) { const int tr = ((v >> 1) << 2) + (mode == 2 ? 2 : 0) + (v & 1); rho0 = tr << 6; n0 = ((rho0 >> 8) << 7) + (rho0 & 127); }
        else { rho0 = v << 6; n0 = rho0; }
    };
    auto gl = [&](int t, float (&regs)[16]) {
        int rho0, kap0, n0; coords(t, rho0, kap0, n0);
        const int n = n0 + tx, nc = n < srcN ? n : srcN - 1;
        const bool nok = n < srcN;
        float raw[16], gs[16];
#pragma unroll
        for (int i = 0; i < 16; ++i) { const int k = kap0 + ty + 8 * i - dstCol0; const int kc = k < 0 ? 0 : (k < srcK ? k : srcK - 1);
            raw[i] = src[(size_t)kc * srcN + nc]; }
        if (gk) {
#pragma unroll
            for (int i = 0; i < 16; ++i) { const int k = kap0 + ty + 8 * i - dstCol0; const int kc = k < 0 ? 0 : (k < srcK ? k : srcK - 1); gs[i] = gk[kc]; }
        } else {
#pragma unroll
            for (int i = 0; i < 16; ++i) gs[i] = 1.0f;
        }
#pragma unroll
        for (int i = 0; i < 16; ++i) { const int k = kap0 + ty + 8 * i - dstCol0; regs[i] = (nok && k >= 0 && k < srcK) ? raw[i] * gs[i] : 0.f; }
    };
    auto emit = [&](int t, float (&regs)[16]) {
#pragma unroll
        for (int i = 0; i < 16; ++i) tile[(ty + 8 * i) * 65 + tx] = regs[i];
        __syncthreads();
        int rho0, kap0, n0; coords(t, rho0, kap0, n0);
        const int tn = t + 2 * gridDim.x;
        if (tn < ntot) gl(tn, regs);
#pragma unroll
        for (int i = 0; i < 8; ++i) { const int row = ty + 8 * i;
            const float lo = tile[(2 * tx) * 65 + row], hi = tile[(2 * tx + 1) * 65 + row];
            *(unsigned*)(dst + (size_t)(rho0 + row) * dstLd + kap0 + 2 * tx) = pk_bf16(lo, hi); }
        __syncthreads();
    };
    const int G = gridDim.x;
    int t = obid();
    if (t < ntot) gl(t, regsA);
    if (t + G < ntot) gl(t + G, regsB);
    while (t < ntot) {
        emit(t, regsA);
        if (t + G < ntot) emit(t + G, regsB);
        t += 2 * G;
    }
}
DEVI void cvt_gu(LAS float* tile, const Params& P, int idx) {
    bf16_t* gut = (bf16_t*)(P.ws + OFF_GUT);
    const size_t wo = (size_t)idx * DM * DFF; const float* g = P.in[2] + (size_t)idx * DM;
    cvt_job(tile, P.in[3] + wo, DM, DFF, gut, DM, 2 * DFF, 0, 1, g);
    cvt_job(tile, P.in[4] + wo, DM, DFF, gut, DM, 2 * DFF, 0, 2, g);
}
DEVI void cvt_dn(LAS float* tile, const Params& P, int idx) {
    cvt_job(tile, P.in[5] + (size_t)idx * DM * DFF, DFF, DM, (bf16_t*)(P.ws + OFF_DT), DFF, DM, 0, 0);
}

DEVI void xprep_rows(const float* in, bf16_t* out, float* rs) {
    const int wave = otid() >> 6, lane = otid() & 63;
    for (int row = obid() * 8 + wave; row < S; row += gridDim.x * 8) {
        const f32x4* p = (const f32x4*)(in + (size_t)row * DM);
        f32x4 v[8]; float ss = 0.f;
#pragma unroll
        for (int i = 0; i < 8; ++i) { v[i] = p[lane + 64 * i]; ss += v[i][0] * v[i][0] + v[i][1] * v[i][1] + v[i][2] * v[i][2] + v[i][3] * v[i][3]; }
        ss = wave_sum(ss);
        if (lane == 0) rs[(size_t)row * 32] = ss;
#pragma unroll
        for (int i = 0; i < 8; ++i) { u32x2 o; o.x = pk_bf16(v[i][0], v[i][1]); o.y = pk_bf16(v[i][2], v[i][3]);
            *(u32x2*)(out + (size_t)row * DM + (lane + 64 * i) * 4) = o; }
    }
}

DEVI void init_phase(LAS float* tile, const Params& P) {
    unsigned char* ws = P.ws;
    if (obid() == 0 && otid() < 64) ((unsigned*)(ws + OFF_CNT))[otid()] = 0u;

    {
        const int* pos = (const int*)P.in[1];
        float* r64 = (float*)(ws + OFF_ROPE64); float* r128 = (float*)(ws + OFF_ROPE128);
        const double L2T = 13.287712379549449;
        for (size_t e = (size_t)obid() * NT + otid(); e < SZ * 96; e += (size_t)gridDim.x * NT) {
            const int t = (int)(e / 96), i = (int)(e % 96);
            const double ps = (double)pos[t];
            double inv; if (i < 32) inv = exp2(-(double)i * (L2T / 32.0)); else inv = exp2(-(double)(i - 32) * (L2T / 64.0));
            const double rev = ps * inv * 0.15915494309189535; const double fr = rev - rint(rev);
            const float c = __builtin_amdgcn_cosf((float)fr), s = __builtin_amdgcn_sinf((float)fr);
            if (i < 32) { r64[(size_t)t * 64 + i] = c; r64[(size_t)t * 64 + 32 + i] = s; }
            else { r128[(size_t)t * 128 + (i - 32)] = c; r128[(size_t)t * 128 + 64 + (i - 32)] = s; }
        }
    }
    cvt_job(tile, P.in[7], DM, 4192, (bf16_t*)(ws + OFF_WINE), DM, EVEN_LD, 0, 0, P.in[6]);
    cvt_job(tile, P.in[9], 512, 1536, (bf16_t*)(ws + OFF_WUQ), 512, 1536, 0, 0);
    cvt_job(tile, P.in[11], 256, 2048, (bf16_t*)(ws + OFF_WUKV), 256, 2048, 0, 0);
    cvt_job(tile, P.in[16], 64, 1024, (bf16_t*)(ws + OFF_LORA), 384, 1024, 0, 0);
    cvt_job(tile, P.in[18], 64, 1024, (bf16_t*)(ws + OFF_LORA) + (size_t)1024 * 384, 384, 1024, 64, 0);
    cvt_job(tile, P.in[19], 160, 1024, (bf16_t*)(ws + OFF_LORA) + (size_t)2048 * 384, 384, 1024, 128, 0);
    cvt_job(tile, P.in[25], DM, DM, (bf16_t*)(ws + OFF_WOUTE), DM, DM, 0, 0);
    cvt_job(tile, P.in[26], DM, 6160, (bf16_t*)(ws + OFF_WINO), DM, ODD_LD, 0, 0, P.in[6] + DM);
    cvt_gu(tile, P, 0);
    cvt_job(tile, P.in[32], DM, DM, (bf16_t*)(ws + OFF_WOUTO), DM, DM, 0, 0);
}

DEVI void eprep1(const Params& P) {
    unsigned char* ws = P.ws;
    const bf16_t* p = (const bf16_t*)(ws + E_P);
    bf16_t* cqn = (bf16_t*)(ws + E_CQN); bf16_t* ckvn = (bf16_t*)(ws + E_CKVN); bf16_t* kr = (bf16_t*)(ws + E_KR);
    bf16_t* rr = (bf16_t*)(ws + E_R); bf16_t* kb = (bf16_t*)(ws + E_KB); bf16_t* vv = (bf16_t*)(ws + E_V); bf16_t* lin = (bf16_t*)(ws + E_LIN);
    const float* qn = P.in[8]; const float* kvn = P.in[10]; const float* mu = P.in[14];
    const int wave = otid() >> 6, lane = otid() & 63;
    for (int t = obid() * 8 + wave; t < S; t += gridDim.x * 8) {
        const bf16_t* row = p + (size_t)t * EVEN_LD;
        float f[8], o[8];
        {
            unpack8(*(const u32x4*)(row + lane * 8), f);
            float ss = 0.f;
#pragma unroll
            for (int j = 0; j < 8; ++j) ss += f[j] * f[j];
            ss = wave_sum(ss); const float r = rsqrtf(ss * (1.0f / 512) + 1e-6f);
#pragma unroll
            for (int j = 0; j < 8; ++j) o[j] = f[j] * r * qn[lane * 8 + j];
            *(u32x4*)(cqn + (size_t)t * 512 + lane * 8) = pack8(o);
        }
        {
            const int l2 = lane & 31;
            unpack8(*(const u32x4*)(row + 512 + l2 * 8), f);
            float ss = 0.f;
#pragma unroll
            for (int j = 0; j < 8; ++j) ss += f[j] * f[j];
            ss = wave_sum(ss) * 0.5f; const float r = rsqrtf(ss * (1.0f / 256) + 1e-6f);
#pragma unroll
            for (int j = 0; j < 8; ++j) o[j] = f[j] * r * kvn[l2 * 8 + j];
            if (lane < 32) *(u32x4*)(ckvn + (size_t)t * 256 + l2 * 8) = pack8(o);
        }
        if (lane < 8) *(u32x4*)(kr + (size_t)t * 64 + lane * 8) = *(const u32x4*)(row + 768 + lane * 8);
        if (lane < 12) { u32x4 z = {0u, 0u, 0u, 0u}; *(u32x4*)(lin + (size_t)t * 384 + 288 + lane * 8) = z; }
#pragma unroll
        for (int it = 0; it < 7; ++it) {
            const int c8 = lane + 64 * it;
            if (c8 >= 420) continue;
            const int c = c8 * 8;
            float cur[8], prv[8];
            unpack8(*(const u32x4*)(row + 832 + c), cur);
            if (t > 0) unpack8(*(const u32x4*)(row - EVEN_LD + 832 + c), prv);
            else {
#pragma unroll
                for (int j = 0; j < 8; ++j) prv[j] = 0.f;
            }
#pragma unroll
            for (int j = 0; j < 8; ++j) o[j] = cur[j] + (prv[j] - cur[j]) * mu[c + j];
            if (c < 1024) *(u32x4*)(rr + (size_t)t * 1024 + c) = pack8(o);
            else if (c < 2048) *(u32x4*)(kb + (size_t)t * 1024 + (c - 1024)) = pack8(o);
            else if (c < 3072) *(u32x4*)(vv + (size_t)t * 1024 + (c - 2048)) = pack8(o);
            else if (c < 3136) {
#pragma unroll
                for (int j = 0; j < 8; ++j) o[j] = tanhf(o[j]);
                *(u32x4*)(lin + (size_t)t * 384 + (c - 3072)) = pack8(o);
            } else if (c < 3200) *(u32x4*)(lin + (size_t)t * 384 + 64 + (c - 3136)) = pack8(o);
            else {
#pragma unroll
                for (int j = 0; j < 8; ++j) o[j] = sigmoidf_(o[j]);
                *(u32x4*)(lin + (size_t)t * 384 + 128 + (c - 3200)) = pack8(o);
            }
        }
    }
}

DEVI void eprep2(const Params& P) {
    unsigned char* ws = P.ws;
    bf16_t* Q = (bf16_t*)(ws + E_Q); const bf16_t* kv = (const bf16_t*)(ws + E_KV); const bf16_t* kr = (const bf16_t*)(ws + E_KR); bf16_t* Km = (bf16_t*)(ws + E_K);
    const bf16_t* kb = (const bf16_t*)(ws + E_KB); const bf16_t* lout = (const bf16_t*)(ws + E_LOUT);
    float* decay = (float*)(ws + E_DECAY); bf16_t* kh = (bf16_t*)(ws + E_KH); bf16_t* na = (bf16_t*)(ws + E_NA); bf16_t* bb = (bf16_t*)(ws + E_BB);
    const float* rope = (const float*)(ws + OFF_ROPE64);
    const float* qhn = P.in[12]; const float* khn = P.in[13];
    const float* w0 = P.in[15]; const float* a0 = P.in[17]; const float* k_k = P.in[20]; const float* k_a = P.in[21];
    const int wave = otid() >> 6, lane = otid() & 63;
    const int head = lane >> 3, sub = lane & 7;
    const float qscale = 0.07216878364870322f * 1.4426950408889634f;
    for (int t = obid() * 8 + wave; t < S; t += gridDim.x * 8) {
        const float* rp = rope + (size_t)t * 64;
        const int ri = 8 * (sub & 3);
        {
            bf16_t* qrow = Q + (size_t)t * 1536 + head * 192;
            float f0[8], f1[8], f2[8];
            unpack8(*(const u32x4*)(qrow + sub * 8), f0); unpack8(*(const u32x4*)(qrow + 64 + sub * 8), f1); unpack8(*(const u32x4*)(qrow + 128 + sub * 8), f2);
            float ss = 0.f;
#pragma unroll
            for (int j = 0; j < 8; ++j) ss += f0[j] * f0[j] + f1[j] * f1[j] + f2[j] * f2[j];
            ss += __shfl_xor(ss, 1); ss += __shfl_xor(ss, 2); ss += __shfl_xor(ss, 4);
            const float r = rsqrtf(ss * (1.0f / 192) + 1e-6f) * qscale;
#pragma unroll
            for (int j = 0; j < 8; ++j) { f0[j] *= r * qhn[sub * 8 + j]; f1[j] *= r * qhn[64 + sub * 8 + j]; f2[j] *= r * qhn[128 + sub * 8 + j]; }
            float o2[8];
#pragma unroll
            for (int j = 0; j < 8; ++j) { const float other = __shfl_xor(f2[j], 4); const float c = rp[ri + j], s = rp[32 + ri + j];
                o2[j] = (sub < 4) ? (f2[j] * c - other * s) : (other * s + f2[j] * c); }
            *(u32x4*)(qrow + sub * 8) = pack8(f0); *(u32x4*)(qrow + 64 + sub * 8) = pack8(f1); *(u32x4*)(qrow + 128 + sub * 8) = pack8(o2);
        }
        {
            const bf16_t* kvrow = kv + (size_t)t * 2048 + head * 256;
            float f0[8], f1[8], f2[8];
            unpack8(*(const u32x4*)(kvrow + sub * 8), f0); unpack8(*(const u32x4*)(kvrow + 64 + sub * 8), f1); unpack8(*(const u32x4*)(kr + (size_t)t * 64 + sub * 8), f2);
            float ss = 0.f;
#pragma unroll
            for (int j = 0; j < 8; ++j) ss += f0[j] * f0[j] + f1[j] * f1[j] + f2[j] * f2[j];
            ss += __shfl_xor(ss, 1); ss += __shfl_xor(ss, 2); ss += __shfl_xor(ss, 4);
            const float r = rsqrtf(ss * (1.0f / 192) + 1e-6f);
#pragma unroll
            for (int j = 0; j < 8; ++j) { f0[j] *= r * khn[sub * 8 + j]; f1[j] *= r * khn[64 + sub * 8 + j]; f2[j] *= r * khn[128 + sub * 8 + j]; }
            float o2[8];
#pragma unroll
            for (int j = 0; j < 8; ++j) { const float other = __shfl_xor(f2[j], 4); const float c = rp[ri + j], s = rp[32 + ri + j];
                o2[j] = (sub < 4) ? (f2[j] * c - other * s) : (other * s + f2[j] * c); }
            bf16_t* krow = Km + (size_t)t * 1536 + head * 192;
            *(u32x4*)(krow + sub * 8) = pack8(f0); *(u32x4*)(krow + 64 + sub * 8) = pack8(f1); *(u32x4*)(krow + 128 + sub * 8) = pack8(o2);
        }
#pragma unroll
        for (int q = 0; q < 2; ++q) {
            const int c = (lane + 64 * q) * 8; const size_t o = (size_t)t * 1024 + c;
            float kbv[8], wl[8], al[8], dec[8], khv[8], nav[8], bbv[8];
            unpack8(*(const u32x4*)(kb + o), kbv); unpack8(*(const u32x4*)(lout + (size_t)t * 3072 + c), wl); unpack8(*(const u32x4*)(lout + (size_t)t * 3072 + 1024 + c), al);
            float nn = 0.f;
#pragma unroll
            for (int j = 0; j < 8; ++j) {
                const float x = -(w0[c + j] + wl[j]);
                const float sp = (x > 20.f) ? x : __logf(1.0f + __expf(x));
                dec[j] = __expf(-__expf(-sp - 0.5f));
                al[j] = sigmoidf_(a0[c + j] + al[j]);
                wl[j] = kbv[j] * k_k[c + j]; nn += wl[j] * wl[j];
            }
            nn += __shfl_xor(nn, 1); nn += __shfl_xor(nn, 2); nn += __shfl_xor(nn, 4);
            const float rn = __builtin_amdgcn_rcpf(fmaxf(__builtin_amdgcn_sqrtf(nn), 1e-12f));
#pragma unroll
            for (int j = 0; j < 8; ++j) { const float kk = wl[j] * rn; khv[j] = kbv[j] * (1.0f + (al[j] - 1.0f) * k_a[c + j]); nav[j] = -kk; bbv[j] = kk * al[j]; }
            *(f32x4*)(decay + o) = (f32x4){dec[0], dec[1], dec[2], dec[3]}; *(f32x4*)(decay + o + 4) = (f32x4){dec[4], dec[5], dec[6], dec[7]};
            *(u32x4*)(kh + o) = pack8(khv); *(u32x4*)(na + o) = pack8(nav); *(u32x4*)(bb + o) = pack8(bbv);
        }
    }
}

template <int DQK> struct AttnCfg { static constexpr int KSTR = DQK * 2 + 16, VSTR = 320, KB = 64 * KSTR, VB = 64 * VSTR, VOFF = 2 * KB, NKC = DQK / 64; };
template <int DQK, int MODE>
DEVI void attn_item(LAS unsigned char* lds, const bf16_t* Qh, int qs, const bf16_t* Kh, int ks_, const bf16_t* Vh, int vs, bf16_t* Oh, int os,
                    float* lse, int lses, int i0, int dil, int res) {
    typedef AttnCfg<DQK> C;
    const int tid = otid(), wave = tid >> 6, lane = tid & 63, l31 = lane & 31, hh = lane >> 5;
    const bool grpB = __builtin_amdgcn_readfirstlane(wave) >= 4;
    const int qidx = i0 + 32 * wave + l31;
    bf16x8 qf[DQK / 16];
    { const bf16_t* qrow = Qh + (size_t)(res + dil * qidx) * qs;
#pragma unroll
      for (int k = 0; k < DQK / 16; ++k) qf[k] = *(const bf16x8*)(qrow + 16 * k + 8 * hh);
#pragma unroll
      for (int k = 0; k < DQK / 16; ++k) asm volatile("" : "+v"(qf[k]));
    }
    const int kbase = MODE ? (i0 - 128) : 0;
    const int j0 = (MODE && kbase < 0) ? 2 : 0;
    const int j1 = MODE ? 6 : (i0 / 64 + 4);
    f32x16 O[4];
#pragma unroll
    for (int c = 0; c < 4; ++c)
#pragma unroll
        for (int j = 0; j < 16; ++j) O[c][j] = 0.f;
    float mrun = -1e30f, lrun = 0.f;
    u32x4 kreg[C::NKC], vreg[2];
    u32x4 pk[4];
#pragma unroll
    for (int i = 0; i < 4; ++i) pk[i] = (u32x4){0u, 0u, 0u, 0u};
    auto gload = [&](int jt) {
        const int kb0 = kbase + 64 * jt;
#pragma unroll
        for (int u = 0; u < C::NKC; ++u) { const int id = tid + NT * u, row = id / (DQK / 8), cc = id % (DQK / 8);
            kreg[u] = *(const u32x4*)(Kh + (size_t)(res + dil * (kb0 + row)) * ks_ + cc * 8); }
#pragma unroll
        for (int u = 0; u < 2; ++u) { const int id = tid + NT * u, row = id >> 4, cc = id & 15;
            vreg[u] = *(const u32x4*)(Vh + (size_t)(res + dil * (kb0 + row)) * vs + cc * 8); }
    };
    auto lstore = [&](int kbi, int vbi) {
        LAS unsigned char* kb_ = lds + kbi * C::KB; LAS unsigned char* vb_ = lds + C::VOFF + vbi * C::VB;
#pragma unroll
        for (int u = 0; u < C::NKC; ++u) { const int id = tid + NT * u, row = id / (DQK / 8), cc = id % (DQK / 8);
            *(LAS u32x4*)(kb_ + row * C::KSTR + cc * 16) = kreg[u]; }
#pragma unroll
        for (int u = 0; u < 2; ++u) { const int id = tid + NT * u, row = id >> 4, cc = id & 15;
            *(LAS u32x4*)(vb_ + row * C::VSTR + cc * 16) = vreg[u]; }
    };
    const int vq = (lane & 15) >> 2, vp = lane & 3, vblk = (lane >> 4) & 1;
    auto pv = [&](int vbi) {
        const LAS unsigned char* vbuf = lds + C::VOFF + vbi * C::VB + (4 * hh + vq) * C::VSTR + (16 * vblk + 4 * vp) * 2;
        auto vld = [&](int i) {
            const int sl = i >> 2, c = i & 3;
            const LAS unsigned char* a = vbuf + (32 * (sl >> 1) + 16 * (sl & 1)) * C::VSTR + 64 * c;
            const s16x4 t0 = __builtin_amdgcn_ds_read_tr16_b64_v4i16((LAS s16x4*)a);
            const s16x4 t1 = __builtin_amdgcn_ds_read_tr16_b64_v4i16((LAS s16x4*)(a + 8 * C::VSTR));
            bf16x8 vf; vf[0] = t0[0]; vf[1] = t0[1]; vf[2] = t0[2]; vf[3] = t0[3]; vf[4] = t1[0]; vf[5] = t1[1]; vf[6] = t1[2]; vf[7] = t1[3];
            return vf;
        };
        bf16x8 fv[3];
        fv[0] = vld(0); fv[1] = vld(1);
        __builtin_amdgcn_sched_barrier(0);
#pragma unroll
        for (int i = 0; i < 16; ++i) {
            if (i + 2 < 16) fv[(i + 2) % 3] = vld(i + 2);
            __builtin_amdgcn_sched_barrier(0);
            bf16x8 pf; __builtin_memcpy(&pf, &pk[i >> 2], 16);
            O[i & 3] = __builtin_amdgcn_mfma_f32_32x32x16_bf16(fv[i % 3], pf, O[i & 3], 0, 0, 0);
            __builtin_amdgcn_sched_barrier(0);
        }
    };
    gload(j0); lstore(0, 0); __syncthreads();
    const int qw0 = i0 + 32 * wave;
    bool havePrev = false;
    int kbi = 0, vbi = 0;
    for (int jt = j0; jt < j1; ++jt) {
        if (jt + 1 < j1) gload(jt + 1);
        const int vprev = vbi == 0 ? 2 : vbi - 1;
        if (grpB && havePrev) pv(vprev);
        havePrev = false;
        const int kb0 = kbase + 64 * jt;
        bool need = kb0 <= qw0 + 31;
        if (MODE) need = need && (kb0 + 63 >= qw0 - 128);
        if (need) {
            const LAS unsigned char* kbuf = lds + kbi * C::KB;
            f32x16 s0, s1;
#pragma unroll
            for (int j = 0; j < 16; ++j) { s0[j] = 0.f; s1[j] = 0.f; }
            {
                constexpr int NK = DQK / 16;
                const LAS unsigned char* kp0 = kbuf + l31 * C::KSTR + 16 * hh;
                const LAS unsigned char* kp1 = kp0 + 32 * C::KSTR;
                bf16x8 fa[3][2];
#pragma unroll
                for (int k = 0; k < 2; ++k) { fa[k][0] = *(const LAS bf16x8*)(kp0 + 32 * k); fa[k][1] = *(const LAS bf16x8*)(kp1 + 32 * k); }
                __builtin_amdgcn_sched_barrier(0);
#pragma unroll
                for (int k = 0; k < NK; ++k) {
                    if (k + 2 < NK) { fa[(k + 2) % 3][0] = *(const LAS bf16x8*)(kp0 + 32 * (k + 2)); fa[(k + 2) % 3][1] = *(const LAS bf16x8*)(kp1 + 32 * (k + 2)); }
                    __builtin_amdgcn_sched_barrier(0);
                    s0 = __builtin_amdgcn_mfma_f32_32x32x16_bf16(fa[k % 3][0], qf[k], s0, 0, 0, 0);
                    s1 = __builtin_amdgcn_mfma_f32_32x32x16_bf16(fa[k % 3][1], qf[k], s1, 0, 0, 0);
                    __builtin_amdgcn_sched_barrier(0);
                }
            }
            const bool domask = MODE ? !(kb0 + 63 <= qw0 && kb0 >= qw0 + 31 - 128) : (kb0 + 63 > qw0);
            if (domask) {
#pragma unroll
                for (int j = 0; j < 16; ++j) { const int key0 = kb0 + 8 * (j >> 2) + 4 * hh + (j & 3), key1 = key0 + 32;
                    bool v0 = key0 <= qidx, v1 = key1 <= qidx;
                    if (MODE) { v0 = v0 && (key0 >= qidx - 128); v1 = v1 && (key1 >= qidx - 128); }
                    s0[j] = v0 ? s0[j] : -1e30f; s1[j] = v1 ? s1[j] : -1e30f; }
            }
            float mx = s0[0];
#pragma unroll
            for (int j = 0; j < 16; ++j) asm("v_max3_f32 %0, %0, %1, %2" : "+v"(mx) : "v"(s0[j]), "v"(s1[j]));
            { const u32x2 sw = __builtin_amdgcn_permlane32_swap(__float_as_uint(mx), __float_as_uint(mx), false, false);
              mx = fmaxf(__uint_as_float(sw[0]), __uint_as_float(sw[1])); }
            const float mnew = fmaxf(mrun, mx);
            const float alpha = __builtin_amdgcn_exp2f(mrun - mnew);
            mrun = mnew;
            const float msafe = fmaxf(mnew, -1e29f);
            float ls = 0.f;
#pragma unroll
            for (int j = 0; j < 16; ++j) { const float p0 = __builtin_amdgcn_exp2f(s0[j] - msafe), p1 = __builtin_amdgcn_exp2f(s1[j] - msafe);
                s0[j] = p0; s1[j] = p1; ls += p0 + p1; }
            lrun = lrun * alpha + ls;
#pragma unroll
            for (int c = 0; c < 4; ++c)
#pragma unroll
                for (int j = 0; j < 16; ++j) O[c][j] *= alpha;
            pk[0] = (u32x4){pk_bf16(s0[0], s0[1]), pk_bf16(s0[2], s0[3]), pk_bf16(s0[4], s0[5]), pk_bf16(s0[6], s0[7])};
            pk[1] = (u32x4){pk_bf16(s0[8], s0[9]), pk_bf16(s0[10], s0[11]), pk_bf16(s0[12], s0[13]), pk_bf16(s0[14], s0[15])};
            pk[2] = (u32x4){pk_bf16(s1[0], s1[1]), pk_bf16(s1[2], s1[3]), pk_bf16(s1[4], s1[5]), pk_bf16(s1[6], s1[7])};
            pk[3] = (u32x4){pk_bf16(s1[8], s1[9]), pk_bf16(s1[10], s1[11]), pk_bf16(s1[12], s1[13]), pk_bf16(s1[14], s1[15])};
            if (!grpB) pv(vbi); else havePrev = true;
        }
        const int kn = kbi ^ 1, vn = vbi == 2 ? 0 : vbi + 1;
        if (jt + 1 < j1) lstore(kn, vn);
        __syncthreads();
        kbi = kn; vbi = vn;
    }
    if (grpB && havePrev) pv(vbi == 0 ? 2 : vbi - 1);
    const float ltot = lrun + __shfl_xor(lrun, 32);
    const float inv = __builtin_amdgcn_rcpf(ltot);
    bf16_t* orow = Oh + (size_t)(res + dil * qidx) * os;
#pragma unroll
    for (int c = 0; c < 4; ++c)
#pragma unroll
        for (int g = 0; g < 4; ++g) { u32x2 w; w.x = pk_bf16(O[c][4 * g] * inv, O[c][4 * g + 1] * inv); w.y = pk_bf16(O[c][4 * g + 2] * inv, O[c][4 * g + 3] * inv);
            *(u32x2*)(orow + 32 * c + 8 * g + 4 * hh) = w; }
    if (lse != nullptr && hh == 0) lse[(size_t)(res + dil * qidx) * lses] = mrun + __builtin_amdgcn_logf(ltot);
}

DEVI float dpp_xor1(float v) { return __int_as_float(__builtin_amdgcn_update_dpp(0, __float_as_int(v), 0xB1, 0xF, 0xF, false)); }
DEVI float dpp_xor2(float v) { return __int_as_float(__builtin_amdgcn_update_dpp(0, __float_as_int(v), 0x4E, 0xF, 0xF, false)); }
constexpr int RW_L = 256, RW_NC = S / RW_L, RW_T = 16, RW_STEPB = 6 * 64 * 4, RW_STAGEB = RW_T * RW_STEPB;
struct RwRegs { f32x4 w0, w1; u32x4 a, b, k, r, v; };
DEVI void rw_gload(RwRegs& R, const Params& P, int head, int t0, int p) {
    unsigned char* ws = P.ws;
    const size_t o = (size_t)(t0 + (p >> 3)) * 1024 + head * 64 + (p & 7) * 8;
    R.w0 = *(const f32x4*)((const float*)(ws + E_DECAY) + o); R.w1 = *(const f32x4*)((const float*)(ws + E_DECAY) + o + 4);
    R.a = *(const u32x4*)((const bf16_t*)(ws + E_NA) + o); R.b = *(const u32x4*)((const bf16_t*)(ws + E_BB) + o);
    R.k = *(const u32x4*)((const bf16_t*)(ws + E_KH) + o); R.r = *(const u32x4*)((const bf16_t*)(ws + E_R) + o); R.v = *(const u32x4*)((const bf16_t*)(ws + E_V) + o);
}
DEVI void rw_st8(LAS unsigned char* d, u32x4 u) { float f[8]; unpack8(u, f); *(LAS f32x4*)d = (f32x4){f[0], f[1], f[2], f[3]}; *(LAS f32x4*)(d + 16) = (f32x4){f[4], f[5], f[6], f[7]}; }
DEVI void rw_lstore(const RwRegs& R, LAS unsigned char* buf, int p) {
    LAS unsigned char* dst = buf + (p >> 3) * RW_STEPB + (p & 7) * 32;
    *(LAS f32x4*)(dst) = R.w0; *(LAS f32x4*)(dst + 16) = R.w1;
    rw_st8(dst + 256, R.a); rw_st8(dst + 512, R.b); rw_st8(dst + 768, R.k); rw_st8(dst + 1024, R.r); rw_st8(dst + 1280, R.v);
}
DEVI void rwkv_A(LAS unsigned char* lds, const Params& P) {
    const int tid = otid(), inst = tid >> 7, p = tid & 127, rp = p >> 2, qc = p & 3;
    float* pu = (float*)(P.ws + E_PU);
    for (int it0 = obid() * 4; it0 < 16 * RW_NC; it0 += gridDim.x * 4) {
        const int item = it0 + inst, head = item / RW_NC, chunk = item % RW_NC, tb = chunk * RW_L;
        f32x2 Pm[2][8], Um[2][8];
#pragma unroll
        for (int h = 0; h < 2; ++h)
#pragma unroll
            for (int j = 0; j < 8; ++j) { Pm[h][j] = (f32x2){(16 * qc + 2 * j == 2 * rp + h) ? 1.f : 0.f, (16 * qc + 2 * j + 1 == 2 * rp + h) ? 1.f : 0.f}; Um[h][j] = (f32x2){0.f, 0.f}; }
        LAS unsigned char* buf = lds + inst * RW_STAGEB;
        RwRegs R; rw_gload(R, P, head, tb, p);
        for (int st = 0; st < RW_L / RW_T; ++st) {
            rw_lstore(R, buf, p);
            __syncthreads();
            if (st + 1 < RW_L / RW_T) rw_gload(R, P, head, tb + (st + 1) * RW_T, p);
            const LAS unsigned char* sb = buf + qc * 64;
#pragma unroll 2
            for (int s = 0; s < RW_T; ++s) {
                const LAS unsigned char* sp = sb + s * RW_STEPB;
                f32x2 w[8], a[8], b[8], k[8];
#pragma unroll
                for (int q = 0; q < 4; ++q) {
                    const f32x4 tw = *(const LAS f32x4*)(sp + q * 16), ta = *(const LAS f32x4*)(sp + 256 + q * 16), tb_ = *(const LAS f32x4*)(sp + 512 + q * 16), tk = *(const LAS f32x4*)(sp + 768 + q * 16);
                    w[2 * q] = (f32x2){tw[0], tw[1]}; w[2 * q + 1] = (f32x2){tw[2], tw[3]}; a[2 * q] = (f32x2){ta[0], ta[1]}; a[2 * q + 1] = (f32x2){ta[2], ta[3]};
                    b[2 * q] = (f32x2){tb_[0], tb_[1]}; b[2 * q + 1] = (f32x2){tb_[2], tb_[3]}; k[2 * q] = (f32x2){tk[0], tk[1]}; k[2 * q + 1] = (f32x2){tk[2], tk[3]};
                }
                const LAS float* vp = (const LAS float*)(sp - qc * 64 + 1280 + rp * 8);
                const float vi[2] = {vp[0], vp[1]};
#pragma unroll
                for (int h = 0; h < 2; ++h) {
                    f32x2 ap = {0.f, 0.f}, au = {0.f, 0.f};
#pragma unroll
                    for (int j = 0; j < 8; ++j) { ap = __builtin_elementwise_fma(Pm[h][j], a[j], ap); au = __builtin_elementwise_fma(Um[h][j], a[j], au); }
                    float sp_ = ap[0] + ap[1], su = au[0] + au[1];
                    sp_ += dpp_xor1(sp_); su += dpp_xor1(su); sp_ += dpp_xor2(sp_); su += dpp_xor2(su);
                    const f32x2 sp2 = {sp_, sp_}, su2 = {su, su}, v2 = {vi[h], vi[h]};
#pragma unroll
                    for (int j = 0; j < 8; ++j) { Pm[h][j] = __builtin_elementwise_fma(Pm[h][j], w[j], sp2 * b[j]);
                        Um[h][j] = __builtin_elementwise_fma(Um[h][j], w[j], __builtin_elementwise_fma(su2, b[j], v2 * k[j])); }
                }
            }
            __syncthreads();
        }
#pragma unroll
        for (int h = 0; h < 2; ++h) {
            float* po = pu + ((size_t)item * 2) * 4096 + (2 * rp + h) * 64 + qc * 16;
#pragma unroll
            for (int q = 0; q < 4; ++q) { *(f32x4*)(po + q * 4) = (f32x4){Pm[h][2 * q][0], Pm[h][2 * q][1], Pm[h][2 * q + 1][0], Pm[h][2 * q + 1][1]};
                *(f32x4*)(po + 4096 + q * 4) = (f32x4){Um[h][2 * q][0], Um[h][2 * q][1], Um[h][2 * q + 1][0], Um[h][2 * q + 1][1]}; }
        }
    }
}
DEVI void rwkv_B(LAS unsigned char* lds, const Params& P, int head) {
    const int tid = otid(), i = tid >> 3, jg = tid & 7;
    const float* pu = (const float*)(P.ws + E_PU); float* sin = (float*)(P.ws + E_SIN);
    LAS float* Sl = (LAS float*)lds;
    LAS float* Pl = (LAS float*)(lds + 64 * 65 * 4);
    float cur[8];
#pragma unroll
    for (int e = 0; e < 8; ++e) { cur[e] = 0.f; Sl[i * 65 + 8 * jg + e] = 0.f; }
    for (int c = 0; c < RW_NC; ++c) {
        const size_t item = (size_t)head * RW_NC + c;
        float* so = sin + item * 4096 + i * 64 + 8 * jg;
        *(f32x4*)so = (f32x4){cur[0], cur[1], cur[2], cur[3]}; *(f32x4*)(so + 4) = (f32x4){cur[4], cur[5], cur[6], cur[7]};
        const float* pc = pu + item * 2 * 4096;
#pragma unroll
        for (int u = 0; u < 2; ++u) { const int id = tid + NT * u; *(LAS f32x4*)(Pl + id * 4) = *(const f32x4*)(pc + id * 4); }
        const f32x4 u0 = *(const f32x4*)(pc + 4096 + i * 64 + 8 * jg), u1 = *(const f32x4*)(pc + 4096 + i * 64 + 8 * jg + 4);
        float acc[8] = {u0[0], u0[1], u0[2], u0[3], u1[0], u1[1], u1[2], u1[3]};
        __syncthreads();
#pragma unroll 8
        for (int k = 0; k < 64; ++k) { const float s = Sl[i * 65 + k]; const f32x4 p0 = *(const LAS f32x4*)(Pl + k * 64 + 8 * jg), p1 = *(const LAS f32x4*)(Pl + k * 64 + 8 * jg + 4);
            acc[0] += s * p0[0]; acc[1] += s * p0[1]; acc[2] += s * p0[2]; acc[3] += s * p0[3]; acc[4] += s * p1[0]; acc[5] += s * p1[1]; acc[6] += s * p1[2]; acc[7] += s * p1[3]; }
        __syncthreads();
#pragma unroll
        for (int e = 0; e < 8; ++e) { cur[e] = acc[e]; Sl[i * 65 + 8 * jg + e] = acc[e]; }
        __syncthreads();
    }
}
DEVI void rwkv_C(LAS unsigned char* lds, const Params& P) {
    const int tid = otid(), inst = tid >> 7, p = tid & 127, rp = p >> 2, qc = p & 3;
    const float* sin = (const float*)(P.ws + E_SIN); bf16_t* y = (bf16_t*)(P.ws + E_Y);
    for (int it0 = obid() * 4; it0 < 16 * RW_NC; it0 += gridDim.x * 4) {
        const int item = it0 + inst, head = item / RW_NC, chunk = item % RW_NC, tb = chunk * RW_L;
        f32x2 St[2][8];
#pragma unroll
        for (int h = 0; h < 2; ++h) { const float* si = sin + (size_t)item * 4096 + (2 * rp + h) * 64 + qc * 16;
#pragma unroll
          for (int q = 0; q < 4; ++q) { const f32x4 x = *(const f32x4*)(si + q * 4); St[h][2 * q] = (f32x2){x[0], x[1]}; St[h][2 * q + 1] = (f32x2){x[2], x[3]}; } }
        LAS unsigned char* buf = lds + inst * RW_STAGEB;
        LAS float* yb = (LAS float*)(lds + 4 * RW_STAGEB + inst * RW_T * 256);
        RwRegs R; rw_gload(R, P, head, tb, p);
        for (int st = 0; st < RW_L / RW_T; ++st) {
            rw_lstore(R, buf, p);
            __syncthreads();
            if (st + 1 < RW_L / RW_T) rw_gload(R, P, head, tb + (st + 1) * RW_T, p);
            const LAS unsigned char* sb = buf + qc * 64;
#pragma unroll 2
            for (int s = 0; s < RW_T; ++s) {
                const LAS unsigned char* sp = sb + s * RW_STEPB;
                f32x2 w[8], a[8], b[8], k[8], r[8];
#pragma unroll
                for (int q = 0; q < 4; ++q) {
                    const f32x4 tw = *(const LAS f32x4*)(sp + q * 16), ta = *(const LAS f32x4*)(sp + 256 + q * 16), tb_ = *(const LAS f32x4*)(sp + 512 + q * 16),
                                tk = *(const LAS f32x4*)(sp + 768 + q * 16), tr = *(const LAS f32x4*)(sp + 1024 + q * 16);
                    w[2 * q] = (f32x2){tw[0], tw[1]}; w[2 * q + 1] = (f32x2){tw[2], tw[3]}; a[2 * q] = (f32x2){ta[0], ta[1]}; a[2 * q + 1] = (f32x2){ta[2], ta[3]};
                    b[2 * q] = (f32x2){tb_[0], tb_[1]}; b[2 * q + 1] = (f32x2){tb_[2], tb_[3]}; k[2 * q] = (f32x2){tk[0], tk[1]}; k[2 * q + 1] = (f32x2){tk[2], tk[3]};
                    r[2 * q] = (f32x2){tr[0], tr[1]}; r[2 * q + 1] = (f32x2){tr[2], tr[3]};
                }
                const LAS float* vp = (const LAS float*)(sp - qc * 64 + 1280 + rp * 8);
                const float vi[2] = {vp[0], vp[1]};
                float yy[2];
#pragma unroll
                for (int h = 0; h < 2; ++h) {
                    f32x2 as = {0.f, 0.f};
#pragma unroll
                    for (int j = 0; j < 8; ++j) as = __builtin_elementwise_fma(St[h][j], a[j], as);
                    float sa = as[0] + as[1];
                    sa += dpp_xor1(sa); sa += dpp_xor2(sa);
                    const f32x2 sa2 = {sa, sa}, v2 = {vi[h], vi[h]};
                    f32x2 ay = {0.f, 0.f};
#pragma unroll
                    for (int j = 0; j < 8; ++j) { St[h][j] = __builtin_elementwise_fma(St[h][j], w[j], __builtin_elementwise_fma(sa2, b[j], v2 * k[j])); ay = __builtin_elementwise_fma(St[h][j], r[j], ay); }
                    float t_ = ay[0] + ay[1];
                    t_ += dpp_xor1(t_); t_ += dpp_xor2(t_);
                    yy[h] = t_;
                }
                if (qc == 0) { yb[s * 64 + 2 * rp] = yy[0]; yb[s * 64 + 2 * rp + 1] = yy[1]; }
            }
            __syncthreads();
            { const LAS float* ys = yb + (p >> 3) * 64 + (p & 7) * 8; float f[8];
#pragma unroll
              for (int j = 0; j < 8; ++j) f[j] = ys[j];
              *(u32x4*)(y + (size_t)(tb + st * RW_T + (p >> 3)) * 1024 + head * 64 + (p & 7) * 8) = pack8(f); }
        }
    }
}

DEVI void emix(LAS unsigned char* lds, const Params& P) {
    unsigned char* ws = P.ws;
    if (obid() < 16) { rwkv_B(lds, P, obid()); }
    unsigned* cnt = (unsigned*)(ws + OFF_CNT) + 32;
    LAS int* slot = (LAS int*)(lds + LDS_BYTES - 16);
    const bf16_t* Q = (const bf16_t*)(ws + E_Q); const bf16_t* Km = (const bf16_t*)(ws + E_K); const bf16_t* kv = (const bf16_t*)(ws + E_KV);
    bf16_t* mix = (bf16_t*)(ws + OFF_XN);
    const int xcd = (int)(xb_xcc_id() & 7u);
    for (;;) {
        if (otid() == 0) { int hsel = -1, nsel = 0;
            for (int k = 0; k < 8; ++k) { const int h = (xcd + k) & 7; const int n = (int)atomicAdd(cnt + h, 1u); if (n < 64) { hsel = h; nsel = n; break; } }
            slot[0] = hsel; slot[1] = nsel; }
        __syncthreads();
        const int head = slot[0], n = slot[1];
        __syncthreads();
        if (head < 0) break;
        const int qb = 63 - n;
        attn_item<192, 0>(lds, Q + head * 192, 1536, Km + head * 192, 1536, kv + head * 256 + 128, 2048, mix + head * 128, 2048, nullptr, 0, qb * 256, 1, 0);
    }
}

DEVI void epost(const Params& P) {
    unsigned char* ws = P.ws;
    const bf16_t* y = (const bf16_t*)(ws + E_Y); const bf16_t* rr = (const bf16_t*)(ws + E_R); const bf16_t* kh = (const bf16_t*)(ws + E_KH); const bf16_t* vv = (const bf16_t*)(ws + E_V);
    const bf16_t* lout = (const bf16_t*)(ws + E_LOUT); bf16_t* mix = (bf16_t*)(ws + OFF_XN);
    const float* r_k = P.in[22]; const float* ln_w = P.in[23]; const float* ln_b = P.in[24];
    const int wave = otid() >> 6, lane = otid() & 63;
    for (int t = obid() * 8 + wave; t < S; t += gridDim.x * 8) {
#pragma unroll
        for (int q = 0; q < 2; ++q) {
            const int c = (lane + 64 * q) * 8; const size_t o = (size_t)t * 1024 + c;
            float yv[8], rv[8], kv_[8], v[8], g[8], ov[8];
            unpack8(*(const u32x4*)(y + o), yv); unpack8(*(const u32x4*)(rr + o), rv); unpack8(*(const u32x4*)(kh + o), kv_); unpack8(*(const u32x4*)(vv + o), v);
            unpack8(*(const u32x4*)(lout + (size_t)t * 3072 + 2048 + c), g);
            float s1 = 0.f, s3 = 0.f;
#pragma unroll
            for (int j = 0; j < 8; ++j) { s1 += yv[j]; s3 += rv[j] * kv_[j] * r_k[c + j]; }
            s1 += __shfl_xor(s1, 1); s3 += __shfl_xor(s3, 1); s1 += __shfl_xor(s1, 2); s3 += __shfl_xor(s3, 2); s1 += __shfl_xor(s1, 4); s3 += __shfl_xor(s3, 4);
            const float mean = s1 * (1.0f / 64);
            float s2 = 0.f;
#pragma unroll
            for (int j = 0; j < 8; ++j) { yv[j] -= mean; s2 += yv[j] * yv[j]; }
            s2 += __shfl_xor(s2, 1); s2 += __shfl_xor(s2, 2); s2 += __shfl_xor(s2, 4);
            const float rs = rsqrtf(s2 * (1.0f / 64) + 64e-5f);
#pragma unroll
            for (int j = 0; j < 8; ++j) ov[j] = ((yv[j] * rs * ln_w[c + j] + ln_b[c + j]) + s3 * v[j]) * g[j];
            *(u32x4*)(mix + (size_t)t * 2048 + 1024 + c) = pack8(ov);
        }
    }
}

DEVI void oprep(const Params& P) {
    unsigned char* ws = P.ws;
    bf16_t* p = (bf16_t*)(ws + O_P); float* lg = (float*)(ws + O_LG);
    const float* rope = (const float*)(ws + OFF_ROPE128);
    const float* qhn = P.in[27]; const float* khn = P.in[28]; const float* wgu = P.in[29]; const float* bg = P.in[30];
    const int wave = otid() >> 6, lane = otid() & 63, head = lane >> 3, sub = lane & 7;
    const float qscale = 0.08838834764831845f * 1.4426950408889634f;
    for (int t = obid() * 8 + wave; t < S; t += gridDim.x * 8) {
        bf16_t* row = p + (size_t)t * ODD_LD;
        const float* rp = rope + (size_t)t * 128;
#pragma unroll
        for (int which = 0; which < 2; ++which) {
            bf16_t* hrow = row + which * 1024 + head * 128;
            const float* nw = which ? khn : qhn;
            float f0[8], f1[8], o0[8], o1[8];
            unpack8(*(const u32x4*)(hrow + sub * 8), f0); unpack8(*(const u32x4*)(hrow + 64 + sub * 8), f1);
            float ss = 0.f;
#pragma unroll
            for (int j = 0; j < 8; ++j) ss += f0[j] * f0[j] + f1[j] * f1[j];
            ss += __shfl_xor(ss, 1); ss += __shfl_xor(ss, 2); ss += __shfl_xor(ss, 4);
            const float r = rsqrtf(ss * (1.0f / 128) + 1e-6f) * (which ? 1.0f : qscale);
#pragma unroll
            for (int j = 0; j < 8; ++j) { const float x1 = f0[j] * r * nw[sub * 8 + j], x2 = f1[j] * r * nw[64 + sub * 8 + j];
                const float c = rp[sub * 8 + j], s = rp[64 + sub * 8 + j];
                o0[j] = x1 * c - x2 * s; o1[j] = x1 * s + x2 * c; }
            *(u32x4*)(hrow + sub * 8) = pack8(o0); *(u32x4*)(hrow + 64 + sub * 8) = pack8(o1);
        }
        float gl[16];
        { float a[8], b[8]; unpack8(*(const u32x4*)(row + 5120), a); unpack8(*(const u32x4*)(row + 5128), b);
#pragma unroll
          for (int j = 0; j < 8; ++j) { gl[j] = a[j]; gl[8 + j] = b[j]; } }
#pragma unroll
        for (int q = 0; q < 2; ++q) {
            const int c0 = (lane + 64 * q) * 4;
            f32x4 acc = *(const f32x4*)(bg + c0);
#pragma unroll
            for (int j = 0; j < 16; ++j) { const f32x4 w = *(const f32x4*)(wgu + j * 512 + c0); acc += w * gl[j]; }
            f32x4 o;
#pragma unroll
            for (int e = 0; e < 4; ++e) { const float x = acc[e]; const float ls = fminf(x, 0.f) - __logf(1.0f + __expf(-fabsf(x))); o[e] = ls * (1.0f / 16); }
            *(f32x4*)(lg + (size_t)t * 512 + c0) = o;
        }
    }
}

DEVI bf16x8 frag_rm(const LAS unsigned char* base, int ld, int m0, int k0, int lane) {
    return *(const LAS bf16x8*)(base + (m0 + (lane & 31)) * ld + (k0 + 8 * (lane >> 5)) * 2);
}
DEVI bf16x8 frag_tr(const LAS unsigned char* base, int ld, int k0, int m0, int lane) {
    const int h = lane >> 5, blk = (lane >> 4) & 1, q = (lane & 15) >> 2, p = lane & 3;
    const LAS unsigned char* a = base + (k0 + 8 * h + q) * ld + (m0 + 16 * blk + 4 * p) * 2;
    const s16x4 t0 = __builtin_amdgcn_ds_read_tr16_b64_v4i16((LAS s16x4*)a);
    const s16x4 t1 = __builtin_amdgcn_ds_read_tr16_b64_v4i16((LAS s16x4*)(a + 4 * ld));
    bf16x8 v; v[0] = t0[0]; v[1] = t0[1]; v[2] = t0[2]; v[3] = t0[3]; v[4] = t1[0]; v[5] = t1[1]; v[6] = t1[2]; v[7] = t1[3];
    return v;
}

constexpr int G_QS = 0, G_KS = 17408, G_VS = 34816, G_SS = 68608, G_AS = 136192;
constexpr int G_LDQ = 272, G_LDV = 528, G_LDA = 144;
DEVI void gla_bcum(LAS unsigned char* lds, const float* lg, int chunk, int head) {
    LAS float* L = (LAS float*)(lds + G_SS);
    const int tid = otid();
#pragma unroll
    for (int u = 0; u < 4; ++u) { const int id = tid + NT * u, row = id >> 5, c4 = id & 31;
        *(LAS f32x4*)(L + row * 128 + c4 * 4) = *(const f32x4*)(lg + (size_t)(chunk * 64 + row) * 512 + head * 128 + c4 * 4); }
    __syncthreads();
    if (tid < 128) { float run = 0.f;
        for (int s = 0; s < 64; ++s) { run += L[s * 128 + tid]; L[s * 128 + tid] = run; } }
    __syncthreads();
}
DEVI void gla_load_v(LAS unsigned char* lds, const bf16_t* p, int chunk, int head) {
    const int tid = otid();
#pragma unroll
    for (int u = 0; u < 4; ++u) { const int id = tid + NT * u, row = id >> 5, cc = id & 31;
        *(LAS u32x4*)(lds + G_VS + row * G_LDV + cc * 16) = *(const u32x4*)(p + (size_t)(chunk * 64 + row) * ODD_LD + 4096 + head * 256 + cc * 8); }
}
DEVI void gla_local(LAS unsigned char* lds, const Params& P, int item) {
    unsigned char* ws = P.ws;
    const bf16_t* p = (const bf16_t*)(ws + O_P); const float* lg = (const float*)(ws + O_LG);
    float* ust = (float*)(ws + O_UST); float* dvec = (float*)(ws + O_DVEC);
    const int chunk = item >> 2, head = item & 3, tid = otid(), wave = tid >> 6, lane = tid & 63;
    gla_bcum(lds, lg, chunk, head);
    const LAS float* L = (const LAS float*)(lds + G_SS);
    gla_load_v(lds, p, chunk, head);
#pragma unroll
    for (int u = 0; u < 2; ++u) { const int id = tid + NT * u, row = id >> 4, cc = id & 15;
        float f[8]; unpack8(*(const u32x4*)(p + (size_t)(chunk * 64 + row) * ODD_LD + 3584 + head * 128 + cc * 8), f);
#pragma unroll
        for (int j = 0; j < 8; ++j) f[j] *= __expf(L[63 * 128 + cc * 8 + j] - L[row * 128 + cc * 8 + j]);
        *(LAS u32x4*)(lds + G_KS + row * G_LDQ + cc * 16) = pack8(f); }
    if (tid < 128) dvec[(size_t)item * 128 + tid] = __expf(L[63 * 128 + tid]);
    __syncthreads();
    const int mt = wave & 3, nb = (wave >> 2) * 4;
    f32x16 acc[4];
#pragma unroll
    for (int n = 0; n < 4; ++n)
#pragma unroll
        for (int j = 0; j < 16; ++j) acc[n][j] = 0.f;
    {
        bf16x8 fa[2], fb[2][4];
        fa[0] = frag_tr(lds + G_KS, G_LDQ, 0, 32 * mt, lane);
#pragma unroll
        for (int n = 0; n < 4; ++n) fb[0][n] = frag_tr(lds + G_VS, G_LDV, 0, 32 * (nb + n), lane);
        __builtin_amdgcn_sched_barrier(0);
#pragma unroll
        for (int ks = 0; ks < 4; ++ks) {
            if (ks + 1 < 4) { fa[(ks + 1) & 1] = frag_tr(lds + G_KS, G_LDQ, 16 * (ks + 1), 32 * mt, lane);
#pragma unroll
                for (int n = 0; n < 4; ++n) fb[(ks + 1) & 1][n] = frag_tr(lds + G_VS, G_LDV, 16 * (ks + 1), 32 * (nb + n), lane); }
            __builtin_amdgcn_sched_barrier(0);
#pragma unroll
            for (int n = 0; n < 4; ++n) acc[n] = __builtin_amdgcn_mfma_f32_32x32x16_bf16(fa[ks & 1], fb[ks & 1][n], acc[n], 0, 0, 0);
            __builtin_amdgcn_sched_barrier(0);
        }
    }
    float* ub = ust + (size_t)item * 128 * 256;
#pragma unroll
    for (int n = 0; n < 4; ++n)
#pragma unroll
        for (int j = 0; j < 16; ++j) { const int k = 32 * mt + 8 * (j >> 2) + 4 * (lane >> 5) + (j & 3), v = 32 * (nb + n) + (lane & 31);
            ub[k * 256 + v] = acc[n][j]; }
    __syncthreads();
}
DEVI void gla_scan(const Params& P) {
    unsigned char* ws = P.ws;
    float* ust = (float*)(ws + O_UST); const float* dvec = (const float*)(ws + O_DVEC);
    const int e = (obid() * NT + otid()) * 4;
    const int dk = (e >> 15) * 128 + ((e >> 8) & 127);
    f32x4 st = {0.f, 0.f, 0.f, 0.f};
    for (int c0 = 0; c0 < 256; c0 += 8) {
        f32x4 u[8]; float d[8];
#pragma unroll
        for (int i = 0; i < 8; ++i) { u[i] = *(const f32x4*)(ust + (size_t)(c0 + i) * 131072 + e); d[i] = dvec[(c0 + i) * 512 + dk]; }
#pragma unroll
        for (int i = 0; i < 8; ++i) { *(f32x4*)(ust + (size_t)(c0 + i) * 131072 + e) = st; st = st * d[i] + u[i]; }
    }
}
DEVI void gla_out(LAS unsigned char* lds, const Params& P, int item) {
    unsigned char* ws = P.ws;
    const bf16_t* p = (const bf16_t*)(ws + O_P); const float* lg = (const float*)(ws + O_LG);
    const float* ust = (const float*)(ws + O_UST); bf16_t* mix = (bf16_t*)(ws + OFF_XN);
    const float* gnorm = P.in[31];
    const int chunk = item >> 2, head = item & 3, tid = otid(), wave = tid >> 6, lane = tid & 63;
    gla_bcum(lds, lg, chunk, head);
    const LAS float* L = (const LAS float*)(lds + G_SS);
    gla_load_v(lds, p, chunk, head);
#pragma unroll
    for (int u = 0; u < 2; ++u) { const int id = tid + NT * u, row = id >> 4, cc = id & 15;
        float fq[8], fk[8];
        unpack8(*(const u32x4*)(p + (size_t)(chunk * 64 + row) * ODD_LD + 3072 + head * 128 + cc * 8), fq);
        unpack8(*(const u32x4*)(p + (size_t)(chunk * 64 + row) * ODD_LD + 3584 + head * 128 + cc * 8), fk);
#pragma unroll
        for (int j = 0; j < 8; ++j) { const float bc = L[row * 128 + cc * 8 + j]; fq[j] *= 0.08838834764831845f * __expf(bc); fk[j] *= __expf(-bc); }
        *(LAS u32x4*)(lds + G_QS + row * G_LDQ + cc * 16) = pack8(fq);
        *(LAS u32x4*)(lds + G_KS + row * G_LDQ + cc * 16) = pack8(fk); }
    __syncthreads();
    {
        const float* sb = ust + (size_t)item * 128 * 256;
#pragma unroll
        for (int u = 0; u < 8; ++u) { const int id = tid + NT * u, row = id >> 5, cc = id & 31;
            const f32x4 a = *(const f32x4*)(sb + row * 256 + cc * 8), b = *(const f32x4*)(sb + row * 256 + cc * 8 + 4);
            u32x4 w; w.x = pk_bf16(a[0], a[1]); w.y = pk_bf16(a[2], a[3]); w.z = pk_bf16(b[0], b[1]); w.w = pk_bf16(b[2], b[3]);
            *(LAS u32x4*)(lds + G_SS + row * G_LDV + cc * 16) = w; }
    }
    if (wave < 4) {
        const int mt = wave >> 1, nt = wave & 1;
        f32x16 acc;
#pragma unroll
        for (int j = 0; j < 16; ++j) acc[j] = 0.f;
        {
            bf16x8 fa[3], fb[3];
#pragma unroll
            for (int ks = 0; ks < 2; ++ks) { fa[ks] = frag_rm(lds + G_QS, G_LDQ, 32 * mt, 16 * ks, lane); fb[ks] = frag_rm(lds + G_KS, G_LDQ, 32 * nt, 16 * ks, lane); }
            __builtin_amdgcn_sched_barrier(0);
#pragma unroll
            for (int ks = 0; ks < 8; ++ks) {
                if (ks + 2 < 8) { fa[(ks + 2) % 3] = frag_rm(lds + G_QS, G_LDQ, 32 * mt, 16 * (ks + 2), lane); fb[(ks + 2) % 3] = frag_rm(lds + G_KS, G_LDQ, 32 * nt, 16 * (ks + 2), lane); }
                __builtin_amdgcn_sched_barrier(0);
                acc = __builtin_amdgcn_mfma_f32_32x32x16_bf16(fa[ks % 3], fb[ks % 3], acc, 0, 0, 0);
                __builtin_amdgcn_sched_barrier(0);
            }
        }
#pragma unroll
        for (int j = 0; j < 16; ++j) { const int tt = 32 * mt + 8 * (j >> 2) + 4 * (lane >> 5) + (j & 3), s = 32 * nt + (lane & 31);
            *(LAS bf16_t*)(lds + G_AS + tt * G_LDA + s * 2) = f2bf(s <= tt ? acc[j] : 0.f); }
    }
    __syncthreads();
    f32x16 o[2];
#pragma unroll
    for (int m = 0; m < 2; ++m)
#pragma unroll
        for (int j = 0; j < 16; ++j) o[m][j] = 0.f;
    {
        bf16x8 fb[2], fa[2][2];
        auto ldstep = [&](int st, bf16x8& b, bf16x8& a0, bf16x8& a1) {
            if (st < 8) { b = frag_tr(lds + G_SS, G_LDV, 16 * st, 32 * wave, lane); a0 = frag_rm(lds + G_QS, G_LDQ, 0, 16 * st, lane); a1 = frag_rm(lds + G_QS, G_LDQ, 32, 16 * st, lane); }
            else { b = frag_tr(lds + G_VS, G_LDV, 16 * (st - 8), 32 * wave, lane); a0 = frag_rm(lds + G_AS, G_LDA, 0, 16 * (st - 8), lane); a1 = frag_rm(lds + G_AS, G_LDA, 32, 16 * (st - 8), lane); }
        };
        ldstep(0, fb[0], fa[0][0], fa[0][1]);
        __builtin_amdgcn_sched_barrier(0);
#pragma unroll
        for (int st = 0; st < 12; ++st) {
            if (st + 1 < 12) ldstep(st + 1, fb[(st + 1) & 1], fa[(st + 1) & 1][0], fa[(st + 1) & 1][1]);
            __builtin_amdgcn_sched_barrier(0);
            o[0] = __builtin_amdgcn_mfma_f32_32x32x16_bf16(fa[st & 1][0], fb[st & 1], o[0], 0, 0, 0);
            o[1] = __builtin_amdgcn_mfma_f32_32x32x16_bf16(fa[st & 1][1], fb[st & 1], o[1], 0, 0, 0);
            __builtin_amdgcn_sched_barrier(0);
        }
    }
    __syncthreads();
    LAS float* Ob = (LAS float*)(lds + G_SS);
#pragma unroll
    for (int m = 0; m < 2; ++m)
#pragma unroll
        for (int j = 0; j < 16; ++j) { const int tt = 32 * m + 8 * (j >> 2) + 4 * (lane >> 5) + (j & 3), v = 32 * wave + (lane & 31); Ob[tt * 260 + v] = o[m][j]; }
    __syncthreads();
    {
        const int row = tid >> 3, sub = tid & 7;
        float vals[32]; float ss = 0.f;
#pragma unroll
        for (int q = 0; q < 8; ++q) { const f32x4 x = *(const LAS f32x4*)(Ob + row * 260 + sub * 32 + q * 4);
#pragma unroll
            for (int e = 0; e < 4; ++e) { vals[q * 4 + e] = x[e]; ss += x[e] * x[e]; } }
        ss += __shfl_xor(ss, 1); ss += __shfl_xor(ss, 2); ss += __shfl_xor(ss, 4);
        const float r = rsqrtf(ss * (1.0f / 256) + 1e-6f);
        const size_t tok = (size_t)(chunk * 64 + row);
        const bf16_t* rd = p + tok * ODD_LD + 5136 + head * 256 + sub * 32;
        bf16_t* mo = mix + tok * 2048 + 1024 + head * 256 + sub * 32;
        const float* gw = gnorm + head * 256 + sub * 32;
        u32x4 gq[4]; f32x4 wq[8];
#pragma unroll
        for (int q = 0; q < 4; ++q) { gq[q] = *(const u32x4*)(rd + q * 8); wq[2 * q] = *(const f32x4*)(gw + q * 8); wq[2 * q + 1] = *(const f32x4*)(gw + q * 8 + 4); }
#pragma unroll
        for (int q = 0; q < 4; ++q) { float g[8], ov[8]; unpack8(gq[q], g);
#pragma unroll
            for (int e = 0; e < 8; ++e) ov[e] = vals[q * 8 + e] * r * wq[2 * q + (e >> 2)][e & 3] * siluf_(g[e]);
            *(u32x4*)(mo + q * 8) = pack8(ov); }
    }
    __syncthreads();
}

DEVI void omerge(const Params& P) {
    unsigned char* ws = P.ws;
    const bf16_t* opat = (const bf16_t*)(ws + O_OPAT); const float* lse = (const float*)(ws + O_LSE); bf16_t* mix = (bf16_t*)(ws + OFF_XN);
    const int wave = otid() >> 6, lane = otid() & 63;
    for (int t = obid() * 8 + wave; t < S; t += gridDim.x * 8) {
#pragma unroll
        for (int q = 0; q < 2; ++q) {
            const int c = (lane + 64 * q) * 8, head = c >> 7;
            const float l0 = lse[(size_t)t * 8 + head], l1 = lse[(SZ + t) * 8 + head], l2 = lse[(2 * SZ + t) * 8 + head];
            const float mx = fmaxf(l0, fmaxf(l1, l2));
            float w0 = __builtin_amdgcn_exp2f(l0 - mx), w1 = __builtin_amdgcn_exp2f(l1 - mx), w2 = __builtin_amdgcn_exp2f(l2 - mx);
            const float inv = __builtin_amdgcn_rcpf(w0 + w1 + w2); w0 *= inv; w1 *= inv; w2 *= inv;
            float a[8], b[8], d[8], o[8];
            unpack8(*(const u32x4*)(opat + (size_t)t * 1024 + c), a); unpack8(*(const u32x4*)(opat + (SZ + t) * 1024 + c), b); unpack8(*(const u32x4*)(opat + (2 * SZ + t) * 1024 + c), d);
#pragma unroll
            for (int e = 0; e < 8; ++e) o[e] = w0 * a[e] + w1 * b[e] + w2 * d[e];
            *(u32x4*)(mix + (size_t)t * 2048 + c) = pack8(o);
        }
    }
}

DEVI void oattn(LAS unsigned char* lds, const Params& P) {
    unsigned char* ws = P.ws;
    if (obid() < 64) gla_scan(P);
    const bf16_t* p = (const bf16_t*)(ws + O_P); bf16_t* opat = (bf16_t*)(ws + O_OPAT); float* lse = (float*)(ws + O_LSE);
    unsigned* cnt = (unsigned*)(ws + OFF_CNT) + 48;
    LAS int* slot = (LAS int*)(lds + LDS_BYTES - 16);
    const int xcd = (int)(xb_xcc_id() & 7u);
    for (;;) {
        if (otid() == 0) { int hsel = -1, nsel = 0;
            for (int k = 0; k < 8; ++k) { const int h = (xcd + k) & 7; const int n = (int)atomicAdd(cnt + h, 1u); if (n < 192) { hsel = h; nsel = n; break; } }
            slot[0] = hsel; slot[1] = nsel; }
        __syncthreads();
        const int head = slot[0], it = slot[1];
        __syncthreads();
        if (head < 0) break;
        const int pat = it >> 6, blk = it & 63;
        const int dil = pat == 0 ? 1 : (pat == 1 ? 4 : 16);
        const int per = 64 / dil;
        const int res = blk / per, i0 = (blk % per) * 256;
        attn_item<128, 1>(lds, p + head * 128, ODD_LD, p + 1024 + head * 128, ODD_LD, p + 2048 + head * 128, ODD_LD,
                          opat + (size_t)pat * SZ * 1024 + head * 128, 1024, lse + (size_t)pat * SZ * 8 + head, 8, i0, dil, res);
    }
}

#define XB_TMO      128
#define XB_XCNT(j)  (256  + 64 * (j))
#define XB_XSUB(j)  (1280 + 64 * (j))
#define XB_XGEN(j)  (2304 + 64 * (j))
#define XB_TOP      3328
#define XB_TOPGEN   3392
#define XCD_BAR_WORDS 3456
#define XB_SPIN_CAP (1u << 20)
DEVI unsigned xb_ld(unsigned* p) { return __hip_atomic_load(p, __ATOMIC_RELAXED, __HIP_MEMORY_SCOPE_AGENT); }
DEVI unsigned xb_add(unsigned* p, unsigned v) { return __hip_atomic_fetch_add(p, v, __ATOMIC_RELAXED, __HIP_MEMORY_SCOPE_AGENT); }
#define XB_SPIN(cond, bar) do { unsigned _sp = 0; while (cond) { __builtin_amdgcn_s_sleep(1); \
    if ((++_sp & 255u) == 0u) { if (xb_ld(&(bar)[XB_TMO])) break; if (_sp > XB_SPIN_CAP) { atomicAdd(&(bar)[XB_TMO], 1u); break; } } } } while (0)
struct XcdBarrier { unsigned* bar; unsigned x; volatile LAS unsigned* st; };
DEVI XcdBarrier xcd_barrier_post(unsigned* bar, volatile LAS unsigned* st) {
    XcdBarrier b; b.bar = bar; b.x = xb_xcc_id(); b.st = st;
    if (otid() == 0) (void)xb_add(&bar[XB_XCNT(b.x)], 1u);
    return b;
}
DEVI void xcd_barrier_complete(unsigned* bar, unsigned x, unsigned& nloc, unsigned& nx) {
    const unsigned G = gridDim.x;
    unsigned sum, cnt, mine, sp = 0u;
    for (;;) {
        sum = 0u; cnt = 0u; mine = 0u;
#pragma unroll
        for (unsigned j = 0; j < 16; ++j) { const unsigned c = xb_ld(&bar[XB_XCNT(j)]); sum += c; cnt += (c > 0u) ? 1u : 0u; mine = (j == x) ? c : mine; }
        if (sum == G) break;
        __builtin_amdgcn_s_sleep(1);
        if ((++sp & 255u) == 0u) { if (xb_ld(&bar[XB_TMO])) break; if (sp > XB_SPIN_CAP) { atomicAdd(&bar[XB_TMO], 1u); break; } }
    }
    nloc = mine > 0u ? mine : 1u; nx = cnt > 0u ? cnt : 1u;
}
DEVI void xcd_barrier(const XcdBarrier& b) {
    asm volatile("s_waitcnt vmcnt(0)" ::: "memory");
    __syncthreads();
    if (otid() == 0) {
        unsigned* bar = b.bar;
        __builtin_amdgcn_s_waitcnt(0);
        unsigned nloc = b.st[0], nx = b.st[1];
        if (nloc == 0u) { xcd_barrier_complete(bar, b.x, nloc, nx); b.st[0] = nloc; b.st[1] = nx; }
        const unsigned old = xb_add(&bar[XB_XSUB(b.x)], 1u);
        const unsigned gen = old / nloc;
        if (old + 1u == (gen + 1u) * nloc) {
            __builtin_amdgcn_fence(__ATOMIC_RELEASE, "agent");
            asm volatile("s_waitcnt vmcnt(0)" ::: "memory");
            const unsigned og = xb_add(&bar[XB_TOP], 1u);
            const unsigned tg = og / nx;
            if (og + 1u == (tg + 1u) * nx) xb_add(&bar[XB_TOPGEN], 1u);
            else XB_SPIN(xb_ld(&bar[XB_TOPGEN]) == tg, bar);
            __builtin_amdgcn_fence(__ATOMIC_ACQUIRE, "agent");
            xb_add(&bar[XB_XGEN(b.x)], 1u);
            asm volatile("s_waitcnt vmcnt(0)" ::: "memory");
        } else {
            XB_SPIN(xb_ld(&bar[XB_XGEN(b.x)]) == gen, bar);
            __builtin_amdgcn_fence(__ATOMIC_ACQUIRE, "agent");
            asm volatile("s_waitcnt vmcnt(0)" ::: "memory");
        }
    }
    __syncthreads();
}

template <int EPI> DEVI void run_gemm(LAS unsigned char* lds, const GemmDesc& d) {
    pg8::StaticOrder so; so.init(S, d.N, (int)gridDim.x, obid());
    if (EPI == 0) { pg8::EpiBf16 e{(bf16_t*)d.out, d.ldc, d.rs_in, d.rs_n}; pg8::gemm_phase(lds, d.A, d.Bt, d.lda, d.ldb, d.K, so, e); }
    else if (EPI == 1) { pg8::EpiSwiglu e{(bf16_t*)d.out, d.ldc, d.rs_in, d.rs_n}; pg8::gemm_phase(lds, d.A, d.Bt, d.lda, d.ldb, d.K, so, e); }
    else { pg8::EpiResid e{(float*)d.out, d.res, d.ldc, d.scale, d.hb_out, d.rs_out}; pg8::gemm_phase(lds, d.A, d.Bt, d.lda, d.ldb, d.K, so, e); }
}
enum { G_GU0 = 0, G_DN0, G_WINE, G_UQ, G_UKV, G_LORA, G_WOUTE, G_GU1, G_DN1, G_GU2, G_DN2, G_WINO, G_WOUTO, G_GU3, G_DN3 };
__global__ void __launch_bounds__(512, 2) hybrid_fwd(const Params P) {
    extern __shared__ __attribute__((aligned(16))) unsigned char smem[];
    LAS unsigned char* lds = (LAS unsigned char*)smem;
    cg::grid_group grid = cg::this_grid();
    volatile LAS unsigned* xst = (volatile LAS unsigned*)(lds + LDS_BYTES - 32);
    unsigned* xbar = (unsigned*)(P.ws + OFF_BAR);
    if (otid() == 0) { xst[0] = 0u; xst[1] = 0u; }
    if (obid() == 0) { for (int i = otid(); i < XCD_BAR_WORDS; i += NT) __hip_atomic_store(xbar + i, 0u, __ATOMIC_RELAXED, __HIP_MEMORY_SCOPE_AGENT); }
    __syncthreads();
#define SYNC() xcd_barrier(xb)
#define PH(k) if (PHMASK & (1 << (k)))
#define REP(bit) for (int rep_ = 0; rep_ < ((PROBE & (bit)) ? 2 : 1); ++rep_)
    REP(4) { PH(0) init_phase((LAS float*)lds, P); }
    REP(4) { PH(1) xprep_rows(P.in[0], (bf16_t*)(P.ws + OFF_XN), (float*)(P.ws + OFF_RS)); }
    grid.sync();
    const XcdBarrier xb = xcd_barrier_post(xbar, xst);
    REP(16) { PH(1) cvt_dn((LAS float*)lds, P, 0); }
    REP(1) { PH(2) run_gemm<1>(lds, P.gd[G_GU0]); SYNC(); }
    REP(16) { PH(1) cvt_gu((LAS float*)lds, P, 1); }
    REP(1) { PH(2) run_gemm<2>(lds, P.gd[G_DN0]); SYNC(); }
    REP(1) { PH(2) run_gemm<0>(lds, P.gd[G_WINE]); SYNC(); }
    REP(4) { PH(3) eprep1(P); SYNC(); }
    REP(1) { PH(2) { run_gemm<0>(lds, P.gd[G_UQ]); run_gemm<0>(lds, P.gd[G_UKV]); run_gemm<0>(lds, P.gd[G_LORA]); } SYNC(); }
    PH(4) eprep2(P); SYNC();
    REP(8) { PH(5) rwkv_A(lds, P); SYNC(); }
    REP(2) { PH(5) emix(lds, P); SYNC(); if (PROBE & 2) { if (obid() == 0 && otid() == 0) *(unsigned*)(P.ws + OFF_CNT) = 0u; SYNC(); } }
    REP(8) { PH(5) rwkv_C(lds, P); SYNC(); }
    REP(4) { PH(6) epost(P); SYNC(); }
    PH(2) run_gemm<2>(lds, P.gd[G_WOUTE]); SYNC();
    REP(16) { PH(1) cvt_dn((LAS float*)lds, P, 1); }
    REP(1) { PH(2) run_gemm<1>(lds, P.gd[G_GU1]); SYNC(); }
    REP(16) { PH(1) cvt_gu((LAS float*)lds, P, 2); }
    PH(2) run_gemm<2>(lds, P.gd[G_DN1]); SYNC();
    REP(16) { PH(1) cvt_dn((LAS float*)lds, P, 2); }
    REP(1) { PH(2) run_gemm<1>(lds, P.gd[G_GU2]); SYNC(); }
    REP(16) { PH(1) cvt_gu((LAS float*)lds, P, 3); }
    PH(2) run_gemm<2>(lds, P.gd[G_DN2]); SYNC();
    REP(1) { PH(2) run_gemm<0>(lds, P.gd[G_WINO]); SYNC(); }
    PH(7) oprep(P); SYNC();
    PH(8) { for (int it = obid(); it < 1024; it += gridDim.x) gla_local(lds, P, it); } SYNC();
    PH(8) oattn(lds, P); SYNC();
    REP(4) { PH(10) { for (int it = obid(); it < 1024; it += gridDim.x) gla_out(lds, P, it); omerge(P); } SYNC(); }
    PH(2) run_gemm<2>(lds, P.gd[G_WOUTO]); SYNC();
    REP(16) { PH(1) cvt_dn((LAS float*)lds, P, 3); }
    REP(1) { PH(2) run_gemm<1>(lds, P.gd[G_GU3]); SYNC(); }
    PH(2) run_gemm<2>(lds, P.gd[G_DN3]);
}

extern "C" void kernel_launch(void* const* d_in, const int* in_sizes, int n_in, void* d_out, int out_size, void* d_ws, size_t ws_size, hipStream_t stream) {
    static int grid_blocks = 0;
    if (!grid_blocks) {
        int dev = 0, cus = 0, per_cu = 0;
        hipGetDevice(&dev);
        hipDeviceGetAttribute(&cus, hipDeviceAttributeMultiprocessorCount, dev);
        hipFuncSetAttribute((const void*)hybrid_fwd, hipFuncAttributeMaxDynamicSharedMemorySize, LDS_BYTES);
        hipOccupancyMaxActiveBlocksPerMultiprocessor(&per_cu, hybrid_fwd, NT, LDS_BYTES);
        if (per_cu < 1) per_cu = 1;
        grid_blocks = cus * 1;
        if (ws_size < WS_NEED) fprintf(stderr, "workspace too small: %zu < %zu\n", ws_size, (size_t)WS_NEED);
    }
    Params P; memset(&P, 0, sizeof(P));
    for (int i = 0; i < 33; ++i) P.in[i] = (const float*)d_in[i];
    P.out = (float*)d_out; P.ws = (unsigned char*)d_ws;
    unsigned char* ws = (unsigned char*)d_ws;
    auto B = [&](size_t off) { return (const bf16_t*)(ws + off); };
    int ng = 0;
    float* rsA = (float*)(ws + OFF_RS); float* rsB = rsA + (size_t)S * 32;
    auto gemm = [&](const bf16_t* A, int lda, const bf16_t* Bt, int ldb, int N, int K, int epi, void* out, int ldc, const float* res, float scale,
                    const float* rs_in, int rs_n, float* rs_out, bf16_t* hb_out) {
        GemmDesc& g = P.gd[ng]; g.A = A; g.Bt = Bt; g.out = out; g.res = res; g.rs_in = rs_in; g.rs_out = rs_out; g.hb_out = hb_out;
        g.lda = lda; g.ldb = ldb; g.ldc = ldc; g.N = N; g.K = K; g.epi = epi; g.scale = scale; g.rs_n = rs_n; return ng++; };
    bf16_t* XN = (bf16_t*)(ws + OFF_XN); bf16_t* HB = (bf16_t*)(ws + OFF_HB);
    const float* fout = (const float*)d_out;
    gemm(XN, DM, B(OFF_GUT), DM, 2 * DFF, DM, 1, ws + OFF_HID, DFF, nullptr, 0.f, rsA, 1, nullptr, nullptr);
    gemm(B(OFF_HID), DFF, B(OFF_DT), DFF, DM, DFF, 2, d_out, DM, (const float*)d_in[0], 0.5f, nullptr, 0, rsB, XN);
    gemm(XN, DM, B(OFF_WINE), DM, EVEN_LD, DM, 0, ws + E_P, EVEN_LD, nullptr, 0.f, rsB, 32, nullptr, nullptr);
    gemm(B(E_CQN), 512, B(OFF_WUQ), 512, 1536, 512, 0, ws + E_Q, 1536, nullptr, 0.f, nullptr, 0, nullptr, nullptr);
    gemm(B(E_CKVN), 256, B(OFF_WUKV), 256, 2048, 256, 0, ws + E_KV, 2048, nullptr, 0.f, nullptr, 0, nullptr, nullptr);
    gemm(B(E_LIN), 384, B(OFF_LORA), 384, 3072, 384, 0, ws + E_LOUT, 3072, nullptr, 0.f, nullptr, 0, nullptr, nullptr);
    gemm(XN, DM, B(OFF_WOUTE), DM, DM, DM, 2, d_out, DM, fout, 1.0f, nullptr, 0, rsB, HB);
    gemm(HB, DM, B(OFF_GUT), DM, 2 * DFF, DM, 1, ws + OFF_HID, DFF, nullptr, 0.f, rsB, 32, nullptr, nullptr);
    gemm(B(OFF_HID), DFF, B(OFF_DT), DFF, DM, DFF, 2, d_out, DM, fout, 0.5f, nullptr, 0, rsB, XN);
    gemm(XN, DM, B(OFF_GUT), DM, 2 * DFF, DM, 1, ws + OFF_HID, DFF, nullptr, 0.f, rsB, 32, nullptr, nullptr);
    gemm(B(OFF_HID), DFF, B(OFF_DT), DFF, DM, DFF, 2, d_out, DM, fout, 0.5f, nullptr, 0, rsB, XN);
    gemm(XN, DM, B(OFF_WINO), DM, ODD_LD, DM, 0, ws + O_P, ODD_LD, nullptr, 0.f, rsB, 32, nullptr, nullptr);
    gemm(XN, DM, B(OFF_WOUTO), DM, DM, DM, 2, d_out, DM, fout, 1.0f, nullptr, 0, rsB, HB);
    gemm(HB, DM, B(OFF_GUT), DM, 2 * DFF, DM, 1, ws + OFF_HID, DFF, nullptr, 0.f, rsB, 32, nullptr, nullptr);
    gemm(B(OFF_HID), DFF, B(OFF_DT), DFF, DM, DFF, 2, d_out, DM, fout, 0.5f, nullptr, 0, nullptr, nullptr);
    P.nsteps = 0;
    void* args[] = {&P};
    hipError_t e = hipLaunchCooperativeKernel((const void*)hybrid_fwd, dim3(grid_blocks), dim3(NT), args, LDS_BYTES, stream);
    if (e != hipSuccess) fprintf(stderr, "cooperative launch failed: %s (grid %d)\n", hipGetErrorString(e), grid_blocks);
}
```

```cpp
#include <hip/hip_runtime.h>
#include <hip/hip_cooperative_groups.h>
#include <cstdio>
#include <cstring>
namespace cg = cooperative_groups;
#ifndef PROBE
#define PROBE 0
#endif
#ifndef PHMASK
#define PHMASK 0xFFFF
#endif

#define LAS __attribute__((address_space(3)))
#define DEVI __device__ __forceinline__
typedef unsigned short bf16_t;
typedef short bf16x8 __attribute__((ext_vector_type(8)));
typedef short s16x4 __attribute__((ext_vector_type(4)));
typedef float f32x4 __attribute__((ext_vector_type(4)));
typedef float f32x2 __attribute__((ext_vector_type(2)));
typedef float f32x16 __attribute__((ext_vector_type(16)));
typedef unsigned u32x4 __attribute__((ext_vector_type(4)));
typedef unsigned u32x2 __attribute__((ext_vector_type(2)));

constexpr int S = 16384, DM = 2048, DFF = 5632;
constexpr int EVEN_LD = 4352, ODD_LD = 6400;
constexpr int NT = 512;
constexpr int LDS_BYTES = 147456;

constexpr size_t SZ = (size_t)S;
constexpr size_t OFF_CNT = 0;
constexpr size_t OFF_RS = 1024;
constexpr size_t OFF_BAR = OFF_RS + 64 * SZ * 4;
constexpr size_t OFF_WINE = OFF_BAR + 16384;
constexpr size_t OFF_WUQ = OFF_WINE + (size_t)EVEN_LD * 2048 * 2;
constexpr size_t OFF_WUKV = OFF_WUQ + (size_t)1536 * 512 * 2;
constexpr size_t OFF_LORA = OFF_WUKV + (size_t)2048 * 256 * 2;
constexpr size_t OFF_WOUTE = OFF_LORA + (size_t)3072 * 384 * 2;
constexpr size_t OFF_WINO = OFF_WOUTE + (size_t)2048 * 2048 * 2;
constexpr size_t OFF_WOUTO = OFF_WINO + (size_t)ODD_LD * 2048 * 2;
constexpr size_t OFF_ROPE64 = OFF_WOUTO + (size_t)2048 * 2048 * 2;
constexpr size_t OFF_ROPE128 = OFF_ROPE64 + SZ * 64 * 4;
constexpr size_t OFF_GUT = OFF_ROPE128 + SZ * 128 * 4;
constexpr size_t OFF_DT = OFF_GUT + (size_t)11264 * 2048 * 2;
constexpr size_t OFF_XN = OFF_DT + (size_t)2048 * 5632 * 2;
constexpr size_t OFF_BIG = OFF_XN + SZ * 2048 * 2;
constexpr size_t OFF_HB = OFF_BIG;
constexpr size_t OFF_HID = OFF_BIG + SZ * 2048 * 2;
constexpr size_t E_P = OFF_BIG;
constexpr size_t E_R = E_P + SZ * EVEN_LD * 2;
constexpr size_t E_KB = E_R + SZ * 1024 * 2;
constexpr size_t E_V = E_KB + SZ * 1024 * 2;
constexpr size_t E_CQN = E_V + SZ * 1024 * 2;
constexpr size_t E_CKVN = E_CQN + SZ * 512 * 2;
constexpr size_t E_LIN = E_CKVN + SZ * 256 * 2;
constexpr size_t E_KR = E_LIN + SZ * 384 * 2;
constexpr size_t E_Q = E_KR + SZ * 64 * 2;
constexpr size_t E_KV = E_Q + SZ * 1536 * 2;
constexpr size_t E_K = E_KV + SZ * 2048 * 2;
constexpr size_t E_LOUT = E_K + SZ * 1536 * 2;
constexpr size_t E_SIN = E_LOUT + SZ * 3072 * 2;
constexpr size_t E_END = E_SIN + (size_t)16 * 64 * 4096 * 4;
constexpr size_t E_PU = E_KB;
constexpr size_t E_DECAY = E_P;
constexpr size_t E_KH = E_P + SZ * 1024 * 4;
constexpr size_t E_NA = E_KH + SZ * 1024 * 2;
constexpr size_t E_BB = E_CQN;
constexpr size_t E_Y = E_KB;
constexpr size_t O_P = OFF_BIG;
constexpr size_t O_LG = O_P + SZ * ODD_LD * 2;
constexpr size_t O_UST = O_LG + SZ * 512 * 4;
constexpr size_t O_DVEC = O_UST + (size_t)256 * 4 * 128 * 256 * 4;
constexpr size_t O_OPAT = O_DVEC + (size_t)256 * 4 * 128 * 4;
constexpr size_t O_LSE = O_OPAT + 3 * SZ * 1024 * 2;
constexpr size_t O_END = O_LSE + 3 * SZ * 8 * 4;
constexpr size_t FFN_END = OFF_HID + SZ * 5632 * 2;
constexpr size_t WS_NEED = (E_END > O_END ? (E_END > FFN_END ? E_END : FFN_END) : (O_END > FFN_END ? O_END : FFN_END));

DEVI int otid() { int t = __builtin_amdgcn_workitem_id_x(); asm volatile("" : "+v"(t)); return t; }
DEVI int obid() { int b = __builtin_amdgcn_workgroup_id_x(); asm volatile("" : "+s"(b)); return b; }
DEVI unsigned pk_bf16(float lo, float hi) { unsigned r; asm("v_cvt_pk_bf16_f32 %0, %1, %2" : "=v"(r) : "v"(lo), "v"(hi)); return r; }
DEVI float bf_lo(unsigned u) { return __uint_as_float(u << 16); }
DEVI float bf_hi(unsigned u) { return __uint_as_float(u & 0xffff0000u); }
DEVI float bf2f(bf16_t b) { return __uint_as_float(((unsigned)b) << 16); }
DEVI bf16_t f2bf(float f) { return (bf16_t)(pk_bf16(f, 0.f) & 0xffffu); }
DEVI unsigned xb_xcc_id() { return (unsigned)__builtin_amdgcn_s_getreg((3 << 11) | 20) & 0xFu; }
DEVI float wave_sum(float v) {
#pragma unroll
    for (int o = 32; o > 0; o >>= 1) v += __shfl_xor(v, o);
    return v;
}
DEVI float sigmoidf_(float x) { return __builtin_amdgcn_rcpf(1.0f + __expf(-x)); }
DEVI float siluf_(float x) { return x * __builtin_amdgcn_rcpf(1.0f + __expf(-x)); }
DEVI void unpack8(u32x4 u, float* f) {
    f[0] = bf_lo(u.x); f[1] = bf_hi(u.x); f[2] = bf_lo(u.y); f[3] = bf_hi(u.y);
    f[4] = bf_lo(u.z); f[5] = bf_hi(u.z); f[6] = bf_lo(u.w); f[7] = bf_hi(u.w);
}
DEVI u32x4 pack8(const float* f) { u32x4 u; u.x = pk_bf16(f[0], f[1]); u.y = pk_bf16(f[2], f[3]); u.z = pk_bf16(f[4], f[5]); u.w = pk_bf16(f[6], f[7]); return u; }

struct GemmDesc { const bf16_t* A; const bf16_t* Bt; void* out; const float* res; const float* rs_in; float* rs_out; bf16_t* hb_out; int lda, ldb, ldc, N, K, epi; float scale; int rs_n; };
struct Step { int kind, a0, a1, a2, sync, p0, p1, p2; };
enum { K_INIT = 0, K_NORM, K_GEMM, K_EPREP1, K_EPREP2, K_EMIX, K_EPOST, K_OPREP, K_OATTN, K_GSCAN, K_OFINAL };
struct Params {
    const float* in[33];
    float* out;
    unsigned char* ws;
    GemmDesc gd[16];
    Step st[32];
    int nsteps, pad;
};

namespace pg8 {
constexpr int BM = 256, BK = 64, HALF = 128, HTB = HALF * BK * 2, STAGE_BYTES = 8 * HTB, NXCD = 8, WGM = 8;
DEVI int lds_byte(int r, int c) { const int st = (r >> 4) * 2 + (c >> 5), rr = r & 15, cc = c & 31, ob = rr * 64 + cc * 2; return st * 1024 + (ob ^ (((ob >> 9) & 1) << 5)); }
DEVI void stage_rc(int b, int& R, int& C) { const int st = b / 1024, sb = b % 1024, swz = sb ^ (((sb >> 9) & 1) << 5); R = (st >> 1) * 16 + swz / 64; C = (st & 1) * 32 + (swz % 64) / 2; }
DEVI int perm32(int rho) { const int n = rho >> 4, i = rho & 15; return 8 * (i >> 2) + 4 * n + (i & 3); }
struct Unit { int pm, pn; };
struct StaticOrder {
    int nM, nN, nwg, G, c;
    DEVI void init(int M, int N, int G_, int c_) { nM = M / BM; nN = N / BM; nwg = nM * nN; G = G_; c = c_; }
    DEVI bool next(int i, Unit& u) const {
        const long L = (long)i * G + c; if (L >= nwg) return false;
        int wgid = (int)L; { const int q = nwg / NXCD, r = nwg % NXCD, xcd = wgid % NXCD, off = wgid / NXCD; wgid = (xcd < r ? xcd * (q + 1) : r * (q + 1) + (xcd - r) * q) + off; }
        const int nig = WGM * nN, gid = wgid / nig, fm = gid * WGM, gsz = (nM - fm) < WGM ? (nM - fm) : WGM;
        u.pm = fm + ((wgid % nig) % gsz); u.pn = (wgid % nig) / gsz; return true;
    }
};
DEVI float row_rstd(const LAS float* rsl, int r) { return rsqrtf((rsl[r] + rsl[256 + r]) * (1.0f / DM) + 1e-6f); }
struct EpiBf16 {
    static constexpr bool PERM = true, HAS_RS = true;
    bf16_t* O_; int ldc_; const float* rs_; int rsn_;
    DEVI void operator()(const f32x4 (&acc)[2][2][4][2], const Unit& u, int wr, int wc, int fr, int fq, const LAS float* rsl) const {
        bf16_t* const O = O_; const int ldc = ldc_; const float* const rs = rs_; const int rsn = rsn_;
        const int row0 = u.pm * BM + wr * 64 + fr, col0 = u.pn * BM + wc * 32 + 8 * fq;
#pragma unroll
        for (int ai = 0; ai < 2; ++ai)
#pragma unroll
            for (int m = 0; m < 4; ++m) { bf16_t* rowp = O + (size_t)(row0 + ai * HALF + m * 16) * ldc + col0;
                const float sc = rs ? row_rstd(rsl, wr * 64 + fr + ai * HALF + m * 16) : 1.0f;
#pragma unroll
                for (int bj = 0; bj < 2; ++bj) { const f32x4 v0 = acc[ai][bj][m][0] * sc, v1 = acc[ai][bj][m][1] * sc;
                    u32x4 w; w.x = pk_bf16(v0[0], v0[1]); w.y = pk_bf16(v0[2], v0[3]); w.z = pk_bf16(v1[0], v1[1]); w.w = pk_bf16(v1[2], v1[3]);
                    *(u32x4*)(rowp + bj * HALF) = w; } }
    }
};
struct EpiSwiglu {
    static constexpr bool PERM = true, HAS_RS = true;
    bf16_t* O_; int ldc_; const float* rs_; int rsn_;
    DEVI void operator()(const f32x4 (&acc)[2][2][4][2], const Unit& u, int wr, int wc, int fr, int fq, const LAS float* rsl) const {
        bf16_t* const O = O_; const int ldc = ldc_; const float* const rs = rs_; const int rsn = rsn_;
        const int row0 = u.pm * BM + wr * 64 + fr, col0 = u.pn * HALF + wc * 32 + 8 * fq;
#pragma unroll
        for (int ai = 0; ai < 2; ++ai)
#pragma unroll
            for (int m = 0; m < 4; ++m) { bf16_t* rowp = O + (size_t)(row0 + ai * HALF + m * 16) * ldc + col0;
                const float sc = row_rstd(rsl, wr * 64 + fr + ai * HALF + m * 16);
                const float k1 = -1.4426950408889634f * sc, k2 = sc * sc;
                float h[8], tt[8];
                const f32x4 guk0 = (acc[ai][0][m][0] * acc[ai][1][m][0]) * k2, guk1 = (acc[ai][0][m][1] * acc[ai][1][m][1]) * k2;
                const f32x4 ta = acc[ai][0][m][0] * k1, tb = acc[ai][0][m][1] * k1;
#pragma unroll
                for (int j = 0; j < 4; ++j) { tt[j] = __builtin_amdgcn_exp2f(ta[j]); tt[4 + j] = __builtin_amdgcn_exp2f(tb[j]); }
                __builtin_amdgcn_sched_barrier(0);
#pragma unroll
                for (int j = 0; j < 8; ++j) tt[j] = __builtin_amdgcn_rcpf(1.0f + tt[j]);
                __builtin_amdgcn_sched_barrier(0);
#pragma unroll
                for (int j = 0; j < 4; ++j) { h[j] = guk0[j] * tt[j]; h[4 + j] = guk1[j] * tt[4 + j]; }
                *(u32x4*)rowp = pack8(h); }
    }
};
struct EpiResid {
    static constexpr bool PERM = false, HAS_RS = false;
    float* C_; const float* R_; int ldc_; float scale_; bf16_t* HB_; float* RS_;
    DEVI void operator()(const f32x4 (&acc)[2][2][4][2], const Unit& u, int wr, int wc, int fr, int fq, const LAS float*) const {
        float* const C = C_; const float* const R = R_; const int ldc = ldc_; bf16_t* const HB = HB_; float* const RS = RS_;
        float scale = scale_; asm volatile("" : "+v"(scale));
        const int row0 = u.pm * BM + wr * 64 + fr, col0 = u.pn * BM + wc * 32 + 4 * fq;
        f32x4 cur[2][2], nxt[2][2];
        { const size_t ro = (size_t)row0 * ldc + col0;
#pragma unroll
          for (int bj = 0; bj < 2; ++bj)
#pragma unroll
              for (int n = 0; n < 2; ++n) cur[bj][n] = *(const f32x4*)(R + ro + bj * HALF + n * 16); }
#pragma unroll
        for (int idx = 0; idx < 8; ++idx) {
            const int ai = idx >> 2, m = idx & 3;
            const size_t ro = (size_t)(row0 + ai * HALF + m * 16) * ldc + col0;
            if (idx + 1 < 8) { const int ai2 = (idx + 1) >> 2, m2 = (idx + 1) & 3; const size_t ro2 = (size_t)(row0 + ai2 * HALF + m2 * 16) * ldc + col0;
#pragma unroll
                for (int bj = 0; bj < 2; ++bj)
#pragma unroll
                    for (int n = 0; n < 2; ++n) nxt[bj][n] = *(const f32x4*)(R + ro2 + bj * HALF + n * 16); }
            float ss = 0.f;
#pragma unroll
            for (int bj = 0; bj < 2; ++bj)
#pragma unroll
                for (int n = 0; n < 2; ++n) {
                    const f32x4 hn = cur[bj][n] + acc[ai][bj][m][n] * scale;
                    *(f32x4*)(C + ro + bj * HALF + n * 16) = hn;
                    if (HB) { u32x2 w; w.x = pk_bf16(hn[0], hn[1]); w.y = pk_bf16(hn[2], hn[3]); *(u32x2*)(HB + ro + bj * HALF + n * 16) = w;
                        ss += hn[0] * hn[0] + hn[1] * hn[1] + hn[2] * hn[2] + hn[3] * hn[3]; } }
            if (HB) { ss += __shfl_xor(ss, 16); ss += __shfl_xor(ss, 32); if (fq == 0) RS[(size_t)(row0 + ai * HALF + m * 16) * 32 + u.pn * 4 + wc] = ss; }
#pragma unroll
            for (int bj = 0; bj < 2; ++bj)
#pragma unroll
                for (int n = 0; n < 2; ++n) cur[bj][n] = nxt[bj][n];
        }
    }
};

template <class Epi>
DEVI void gemm_phase(LAS unsigned char* lds, const bf16_t* gA, const bf16_t* gBt, const int lda, const int ldb, const int K, const StaticOrder S_, const Epi E) {
    const int tid = otid(), wid = __builtin_amdgcn_readfirstlane(tid >> 6), lane = tid & 63, wr = wid >> 2, wc = wid & 3, fr = lane & 15, fq = lane >> 4;
    const int nt = K / BK;
    unsigned voffA[2], voffB[2];
#pragma unroll
    for (int i = 0; i < 2; ++i) { int R, C; stage_rc(tid * 16 + i * 8192, R, C); const int Rb = Epi::PERM ? ((R & ~31) + perm32(R & 31)) : R;
        voffA[i] = (unsigned)(R * lda + C) * 2u; voffB[i] = (unsigned)(Rb * ldb + C) * 2u; }
    const size_t kstep = (size_t)(BK * 2);
    const size_t hstepA = (size_t)HALF * lda * 2, hstepB = (size_t)HALF * ldb * 2;
    const size_t tstepA = 2 * hstepA, tstepB = 2 * hstepB;
    const unsigned ldsw = (unsigned)wid * 1024u;
    const int aoff = lds_byte(wr * 64 + fr, fq * 8), boff = lds_byte(wc * 32 + fr, fq * 8);
#define PG8_SA(b, h) (((b) * 2 + (h)) * HTB)
#define PG8_SB(b, h) ((4 + (b) * 2 + (h)) * HTB)
#define PG8_STAGE(bufoff, gbase, voff) do { _Pragma("unroll") for (int _i = 0; _i < 2; ++_i) \
        __builtin_amdgcn_global_load_lds((const unsigned*)((const char*)(gbase) + (voff)[_i]), (LAS unsigned*)(lds + (bufoff) + ldsw + _i * 8192), 16, 0, 0); } while (0)
#define PG8_LDA(dst, b, h) do { _Pragma("unroll") for (int m = 0; m < 4; ++m) _Pragma("unroll") for (int k = 0; k < 2; ++k) dst[m][k] = *(const LAS bf16x8*)(lds + PG8_SA(b, h) + aoff + m * 2048 + k * 1024); } while (0)
#define PG8_LDB(dst, b, h) do { _Pragma("unroll") for (int n = 0; n < 2; ++n) _Pragma("unroll") for (int k = 0; k < 2; ++k) dst[n][k] = *(const LAS bf16x8*)(lds + PG8_SB(b, h) + boff + n * 2048 + k * 1024); } while (0)
#define PG8_MMA(ai, bj, At, Bt) do { __builtin_amdgcn_s_setprio(1); _Pragma("unroll") for (int m = 0; m < 4; ++m) _Pragma("unroll") for (int n = 0; n < 2; ++n) _Pragma("unroll") for (int k = 0; k < 2; ++k) \
        acc[ai][bj][m][n] = __builtin_amdgcn_mfma_f32_16x16x32_bf16(Bt[n][k], At[m][k], acc[ai][bj][m][n], 0, 0, 0); __builtin_amdgcn_s_setprio(0); } while (0)
#define PG8_WAIT_V(n) asm volatile("s_waitcnt vmcnt(" #n ")" ::: "memory")
#define PG8_WAIT_L(n) asm volatile("s_waitcnt lgkmcnt(" #n ")" ::: "memory")
#define PG8_BAR __builtin_amdgcn_s_barrier()
#define PG8_SCHED __builtin_amdgcn_sched_barrier(0)
    Unit cur, nxt; int ui = 0;
    if (!S_.next(0, cur)) return;
    auto rs_prefetch = [&](const Unit& u, int par) {
        if constexpr (Epi::HAS_RS) { if (E.rs_) {
            const int r = tid & 255, hf = tid >> 8; float s = 0.f;
            const float* base = E.rs_ + (size_t)(u.pm * BM + r) * 32 + hf * 16;
            if (E.rsn_ == 32) {
                const f32x4 a = *(const f32x4*)base, b = *(const f32x4*)(base + 4), c = *(const f32x4*)(base + 8), d = *(const f32x4*)(base + 12);
                s = ((a[0] + a[1]) + (a[2] + a[3])) + ((b[0] + b[1]) + (b[2] + b[3])) + ((c[0] + c[1]) + (c[2] + c[3])) + ((d[0] + d[1]) + (d[2] + d[3]));
            } else if (hf == 0) s = base[0];
            *(LAS float*)(lds + STAGE_BYTES + par * 2048 + hf * 1024 + r * 4) = s; } }
    };
    f32x4 acc[2][2][4][2];
#pragma unroll
    for (int a = 0; a < 2; ++a)
#pragma unroll
        for (int b = 0; b < 2; ++b)
#pragma unroll
            for (int m = 0; m < 4; ++m)
#pragma unroll
                for (int n = 0; n < 2; ++n) acc[a][b][m][n] = (f32x4){0.f, 0.f, 0.f, 0.f};
    bf16x8 At[4][2], B0[2][2], B1[2][2];
    const char* cA = (const char*)gA + (size_t)cur.pm * tstepA; const char* cB = (const char*)gBt + (size_t)cur.pn * tstepB;
    PG8_STAGE(PG8_SB(0, 0), cB, voffB); PG8_STAGE(PG8_SA(0, 0), cA, voffA); PG8_STAGE(PG8_SB(0, 1), cB + hstepB, voffB); PG8_STAGE(PG8_SA(0, 1), cA + hstepA, voffA);
    if (wr == 1) PG8_BAR;
    PG8_WAIT_V(4); PG8_BAR;
    PG8_STAGE(PG8_SB(1, 0), cB + kstep, voffB); PG8_STAGE(PG8_SA(1, 0), cA + kstep, voffA); PG8_STAGE(PG8_SB(1, 1), cB + hstepB + kstep, voffB);
    PG8_WAIT_V(6); PG8_BAR;
    rs_prefetch(cur, 0);
    for (;;) {
        const bool has_next = S_.next(ui + 1, nxt);
        const char* nA = has_next ? (const char*)gA + (size_t)nxt.pm * tstepA : cA; const char* nB = has_next ? (const char*)gBt + (size_t)nxt.pn * tstepB : cB;
        for (int t = 0; t < nt; t += 2) {
            const bool last = (t == nt - 2);
            const char* a1 = cA + (size_t)(t + 1) * kstep;
            const char* a2 = last ? nA : cA + (size_t)(t + 2) * kstep; const char* b2 = last ? nB : cB + (size_t)(t + 2) * kstep;
            const char* a3 = a2 + kstep; const char* b3 = b2 + kstep;
            PG8_LDB(B0, 0, 0); PG8_SCHED; PG8_LDA(At, 0, 0); PG8_STAGE(PG8_SA(1, 1), a1 + hstepA, voffA);
            PG8_WAIT_L(8); PG8_BAR; PG8_WAIT_L(0); PG8_MMA(0, 0, At, B0); PG8_BAR; PG8_SCHED;
            PG8_LDB(B1, 0, 1); PG8_STAGE(PG8_SB(0, 0), b2, voffB);
            PG8_BAR; PG8_WAIT_L(0); PG8_MMA(0, 1, At, B1); PG8_BAR;
            PG8_LDA(At, 0, 1); PG8_STAGE(PG8_SA(0, 0), a2, voffA);
            PG8_BAR; PG8_WAIT_L(0); PG8_MMA(1, 0, At, B0); PG8_BAR; PG8_SCHED;
            PG8_STAGE(PG8_SB(0, 1), b2 + hstepB, voffB);
            PG8_WAIT_V(6); PG8_BAR; PG8_MMA(1, 1, At, B1); PG8_BAR;
            PG8_LDB(B0, 1, 0); PG8_SCHED; PG8_LDA(At, 1, 0); PG8_STAGE(PG8_SA(0, 1), a2 + hstepA, voffA);
            PG8_WAIT_L(8); PG8_BAR; PG8_WAIT_L(0); PG8_MMA(0, 0, At, B0); PG8_BAR; PG8_SCHED;
            PG8_LDB(B1, 1, 1); PG8_STAGE(PG8_SB(1, 0), b3, voffB);
            PG8_BAR; PG8_WAIT_L(0); PG8_MMA(0, 1, At, B1); PG8_BAR;
            PG8_LDA(At, 1, 1); PG8_STAGE(PG8_SA(1, 0), a3, voffA);
            PG8_BAR; PG8_WAIT_L(0); PG8_MMA(1, 0, At, B0); PG8_BAR; PG8_SCHED;
            PG8_STAGE(PG8_SB(1, 1), b3 + hstepB, voffB);
            PG8_WAIT_V(6); PG8_BAR; PG8_MMA(1, 1, At, B1); PG8_BAR;
        }
        E(acc, cur, wr, wc, fr, fq, (const LAS float*)(lds + STAGE_BYTES + (ui & 1) * 2048));
        if (!has_next) break;
#pragma unroll
        for (int a = 0; a < 2; ++a)
#pragma unroll
            for (int b = 0; b < 2; ++b)
#pragma unroll
                for (int m = 0; m < 4; ++m)
#pragma unroll
                    for (int n = 0; n < 2; ++n) acc[a][b][m][n] = (f32x4){0.f, 0.f, 0.f, 0.f};
        cur = nxt; cA = nA; cB = nB; ++ui;
        rs_prefetch(cur, ui & 1);
    }
    PG8_WAIT_V(0);
    if (wr == 0) PG8_BAR;
    PG8_BAR;
#undef PG8_SA
#undef PG8_SB
#undef PG8_STAGE
#undef PG8_LDA
#undef PG8_LDB
#undef PG8_MMA
#undef PG8_WAIT_V
#undef PG8_WAIT_L
#undef PG8_BAR
#undef PG8_SCHED
}
}

DEVI void cvt_job(LAS float* tile, const float* src, int srcK, int srcN, bf16_t* dst, int dstLd, int dstRows, int dstCol0, int mode, const float* gk = nullptr) {
    const int tid = otid(), ntc = dstLd >> 7, nvr = mode ? (dstRows >> 7) : (dstRows >> 6), ntot = nvr * ntc;
    const int tx = tid & 63, ty = tid >> 6;
    float regsA[16], regsB[16];
    auto coords = [&](int t, int& rho0, int& kap0, int& n0) {
        const int tc = t / nvr, v = t - tc * nvr; kap0 = tc << 7;
        if (mode) { const int tr = ((v >> 1) << 2) + (mode == 2 ? 2 : 0) + (v & 1); rho0 = tr << 6; n0 = ((rho0 >> 8) << 7) + (rho0 & 127); }
        else { rho0 = v << 6; n0 = rho0; }
    };
    auto gl = [&](int t, float (&regs)[16]) {
        int rho0, kap0, n0; coords(t, rho0, kap0, n0);
        const int n = n0 + tx, nc = n < srcN ? n : srcN - 1;
        const bool nok = n < srcN;
        float raw[16], gs[16];
#pragma unroll
        for (int i = 0; i < 16; ++i) { const int k = kap0 + ty + 8 * i - dstCol0; const int kc = k < 0 ? 0 : (k < srcK ? k : srcK - 1);
            raw[i] = src[(size_t)kc * srcN + nc]; }
        if (gk) {
#pragma unroll
            for (int i = 0; i < 16; ++i) { const int k = kap0 + ty + 8 * i - dstCol0; const int kc = k < 0 ? 0 : (k < srcK ? k : srcK - 1); gs[i] = gk[kc]; }
        } else {
#pragma unroll
            for (int i = 0; i < 16; ++i) gs[i] = 1.0f;
        }
#pragma unroll
        for (int i = 0; i < 16; ++i) { const int k = kap0 + ty + 8 * i - dstCol0; regs[i] = (nok && k >= 0 && k < srcK) ? raw[i] * gs[i] : 0.f; }
    };
    auto emit = [&](int t, float (&regs)[16]) {
#pragma unroll
        for (int i = 0; i < 16; ++i) tile[(ty + 8 * i) * 65 + tx] = regs[i];
        __syncthreads();
        int rho0, kap0, n0; coords(t, rho0, kap0, n0);
        const int tn = t + 2 * gridDim.x;
        if (tn < ntot) gl(tn, regs);
#pragma unroll
        for (int i = 0; i < 8; ++i) { const int row = ty + 8 * i;
            const float lo = tile[(2 * tx) * 65 + row], hi = tile[(2 * tx + 1) * 65 + row];
            *(unsigned*)(dst + (size_t)(rho0 + row) * dstLd + kap0 + 2 * tx) = pk_bf16(lo, hi); }
        __syncthreads();
    };
    const int G = gridDim.x;
    int t = obid();
    if (t < ntot) gl(t, regsA);
    if (t + G < ntot) gl(t + G, regsB);
    while (t < ntot) {
        emit(t, regsA);
        if (t + G < ntot) emit(t + G, regsB);
        t += 2 * G;
    }
}
DEVI void cvt_gu(LAS float* tile, const Params& P, int idx) {
    bf16_t* gut = (bf16_t*)(P.ws + OFF_GUT);
    const size_t wo = (size_t)idx * DM * DFF; const float* g = P.in[2] + (size_t)idx * DM;
    cvt_job(tile, P.in[3] + wo, DM, DFF, gut, DM, 2 * DFF, 0, 1, g);
    cvt_job(tile, P.in[4] + wo, DM, DFF, gut, DM, 2 * DFF, 0, 2, g);
}
DEVI void cvt_dn(LAS float* tile, const Params& P, int idx) {
    cvt_job(tile, P.in[5] + (size_t)idx * DM * DFF, DFF, DM, (bf16_t*)(P.ws + OFF_DT), DFF, DM, 0, 0);
}

DEVI void xprep_rows(const float* in, bf16_t* out, float* rs) {
    const int wave = otid() >> 6, lane = otid() & 63;
    for (int row = obid() * 8 + wave; row < S; row += gridDim.x * 8) {
        const f32x4* p = (const f32x4*)(in + (size_t)row * DM);
        f32x4 v[8]; float ss = 0.f;
#pragma unroll
        for (int i = 0; i < 8; ++i) { v[i] = p[lane + 64 * i]; ss += v[i][0] * v[i][0] + v[i][1] * v[i][1] + v[i][2] * v[i][2] + v[i][3] * v[i][3]; }
        ss = wave_sum(ss);
        if (lane == 0) rs[(size_t)row * 32] = ss;
#pragma unroll
        for (int i = 0; i < 8; ++i) { u32x2 o; o.x = pk_bf16(v[i][0], v[i][1]); o.y = pk_bf16(v[i][2], v[i][3]);
            *(u32x2*)(out + (size_t)row * DM + (lane + 64 * i) * 4) = o; }
    }
}

DEVI void init_phase(LAS float* tile, const Params& P) {
    unsigned char* ws = P.ws;
    if (obid() == 0 && otid() < 64) ((unsigned*)(ws + OFF_CNT))[otid()] = 0u;

    {
        const int* pos = (const int*)P.in[1];
        float* r64 = (float*)(ws + OFF_ROPE64); float* r128 = (float*)(ws + OFF_ROPE128);
        const double L2T = 13.287712379549449;
        for (size_t e = (size_t)obid() * NT + otid(); e < SZ * 96; e += (size_t)gridDim.x * NT) {
            const int t = (int)(e / 96), i = (int)(e % 96);
            const double ps = (double)pos[t];
            double inv; if (i < 32) inv = exp2(-(double)i * (L2T / 32.0)); else inv = exp2(-(double)(i - 32) * (L2T / 64.0));
            const double rev = ps * inv * 0.15915494309189535; const double fr = rev - rint(rev);
            const float c = __builtin_amdgcn_cosf((float)fr), s = __builtin_amdgcn_sinf((float)fr);
            if (i < 32) { r64[(size_t)t * 64 + i] = c; r64[(size_t)t * 64 + 32 + i] = s; }
            else { r128[(size_t)t * 128 + (i - 32)] = c; r128[(size_t)t * 128 + 64 + (i - 32)] = s; }
        }
    }
    cvt_job(tile, P.in[7], DM, 4192, (bf16_t*)(ws + OFF_WINE), DM, EVEN_LD, 0, 0, P.in[6]);
    cvt_job(tile, P.in[9], 512, 1536, (bf16_t*)(ws + OFF_WUQ), 512, 1536, 0, 0);
    cvt_job(tile, P.in[11], 256, 2048, (bf16_t*)(ws + OFF_WUKV), 256, 2048, 0, 0);
    cvt_job(tile, P.in[16], 64, 1024, (bf16_t*)(ws + OFF_LORA), 384, 1024, 0, 0);
    cvt_job(tile, P.in[18], 64, 1024, (bf16_t*)(ws + OFF_LORA) + (size_t)1024 * 384, 384, 1024, 64, 0);
    cvt_job(tile, P.in[19], 160, 1024, (bf16_t*)(ws + OFF_LORA) + (size_t)2048 * 384, 384, 1024, 128, 0);
    cvt_job(tile, P.in[25], DM, DM, (bf16_t*)(ws + OFF_WOUTE), DM, DM, 0, 0);
    cvt_job(tile, P.in[26], DM, 6160, (bf16_t*)(ws + OFF_WINO), DM, ODD_LD, 0, 0, P.in[6] + DM);
    cvt_gu(tile, P, 0);
    cvt_job(tile, P.in[32], DM, DM, (bf16_t*)(ws + OFF_WOUTO), DM, DM, 0, 0);
}

DEVI void eprep1(const Params& P) {
    unsigned char* ws = P.ws;
    const bf16_t* p = (const bf16_t*)(ws + E_P);
    bf16_t* cqn = (bf16_t*)(ws + E_CQN); bf16_t* ckvn = (bf16_t*)(ws + E_CKVN); bf16_t* kr = (bf16_t*)(ws + E_KR);
    bf16_t* rr = (bf16_t*)(ws + E_R); bf16_t* kb = (bf16_t*)(ws + E_KB); bf16_t* vv = (bf16_t*)(ws + E_V); bf16_t* lin = (bf16_t*)(ws + E_LIN);
    const float* qn = P.in[8]; const float* kvn = P.in[10]; const float* mu = P.in[14];
    const int wave = otid() >> 6, lane = otid() & 63;
    for (int t = obid() * 8 + wave; t < S; t += gridDim.x * 8) {
        const bf16_t* row = p + (size_t)t * EVEN_LD;
        float f[8], o[8];
        {
            unpack8(*(const u32x4*)(row + lane * 8), f);
            float ss = 0.f;
#pragma unroll
            for (int j = 0; j < 8; ++j) ss += f[j] * f[j];
            ss = wave_sum(ss); const float r = rsqrtf(ss * (1.0f / 512) + 1e-6f);
#pragma unroll
            for (int j = 0; j < 8; ++j) o[j] = f[j] * r * qn[lane * 8 + j];
            *(u32x4*)(cqn + (size_t)t * 512 + lane * 8) = pack8(o);
        }
        {
            const int l2 = lane & 31;
            unpack8(*(const u32x4*)(row + 512 + l2 * 8), f);
            float ss = 0.f;
#pragma unroll
            for (int j = 0; j < 8; ++j) ss += f[j] * f[j];
            ss = wave_sum(ss) * 0.5f; const float r = rsqrtf(ss * (1.0f / 256) + 1e-6f);
#pragma unroll
            for (int j = 0; j < 8; ++j) o[j] = f[j] * r * kvn[l2 * 8 + j];
            if (lane < 32) *(u32x4*)(ckvn + (size_t)t * 256 + l2 * 8) = pack8(o);
        }
        if (lane < 8) *(u32x4*)(kr + (size_t)t * 64 + lane * 8) = *(const u32x4*)(row + 768 + lane * 8);
        if (lane < 12) { u32x4 z = {0u, 0u, 0u, 0u}; *(u32x4*)(lin + (size_t)t * 384 + 288 + lane * 8) = z; }
#pragma unroll
        for (int it = 0; it < 7; ++it) {
            const int c8 = lane + 64 * it;
            if (c8 >= 420) continue;
            const int c = c8 * 8;
            float cur[8], prv[8];
            unpack8(*(const u32x4*)(row + 832 + c), cur);
            if (t > 0) unpack8(*(const u32x4*)(row - EVEN_LD + 832 + c), prv);
            else {
#pragma unroll
                for (int j = 0; j < 8; ++j) prv[j] = 0.f;
            }
#pragma unroll
            for (int j = 0; j < 8; ++j) o[j] = cur[j] + (prv[j] - cur[j]) * mu[c + j];
            if (c < 1024) *(u32x4*)(rr + (size_t)t * 1024 + c) = pack8(o);
            else if (c < 2048) *(u32x4*)(kb + (size_t)t * 1024 + (c - 1024)) = pack8(o);
            else if (c < 3072) *(u32x4*)(vv + (size_t)t * 1024 + (c - 2048)) = pack8(o);
            else if (c < 3136) {
#pragma unroll
                for (int j = 0; j < 8; ++j) o[j] = tanhf(o[j]);
                *(u32x4*)(lin + (size_t)t * 384 + (c - 3072)) = pack8(o);
            } else if (c < 3200) *(u32x4*)(lin + (size_t)t * 384 + 64 + (c - 3136)) = pack8(o);
            else {
#pragma unroll
                for (int j = 0; j < 8; ++j) o[j] = sigmoidf_(o[j]);
                *(u32x4*)(lin + (size_t)t * 384 + 128 + (c - 3200)) = pack8(o);
            }
        }
    }
}

DEVI void eprep2(const Params& P) {
    unsigned char* ws = P.ws;
    bf16_t* Q = (bf16_t*)(ws + E_Q); const bf16_t* kv = (const bf16_t*)(ws + E_KV); const bf16_t* kr = (const bf16_t*)(ws + E_KR); bf16_t* Km = (bf16_t*)(ws + E_K);
    const bf16_t* kb = (const bf16_t*)(ws + E_KB); const bf16_t* lout = (const bf16_t*)(ws + E_LOUT);
    float* decay = (float*)(ws + E_DECAY); bf16_t* kh = (bf16_t*)(ws + E_KH); bf16_t* na = (bf16_t*)(ws + E_NA); bf16_t* bb = (bf16_t*)(ws + E_BB);
    const float* rope = (const float*)(ws + OFF_ROPE64);
    const float* qhn = P.in[12]; const float* khn = P.in[13];
    const float* w0 = P.in[15]; const float* a0 = P.in[17]; const float* k_k = P.in[20]; const float* k_a = P.in[21];
    const int wave = otid() >> 6, lane = otid() & 63;
    const int head = lane >> 3, sub = lane & 7;
    const float qscale = 0.07216878364870322f * 1.4426950408889634f;
    for (int t = obid() * 8 + wave; t < S; t += gridDim.x * 8) {
        const float* rp = rope + (size_t)t * 64;
        const int ri = 8 * (sub & 3);
        {
            bf16_t* qrow = Q + (size_t)t * 1536 + head * 192;
            float f0[8], f1[8], f2[8];
            unpack8(*(const u32x4*)(qrow + sub * 8), f0); unpack8(*(const u32x4*)(qrow + 64 + sub * 8), f1); unpack8(*(const u32x4*)(qrow + 128 + sub * 8), f2);
            float ss = 0.f;
#pragma unroll
            for (int j = 0; j < 8; ++j) ss += f0[j] * f0[j] + f1[j] * f1[j] + f2[j] * f2[j];
            ss += __shfl_xor(ss, 1); ss += __shfl_xor(ss, 2); ss += __shfl_xor(ss, 4);
            const float r = rsqrtf(ss * (1.0f / 192) + 1e-6f) * qscale;
#pragma unroll
            for (int j = 0; j < 8; ++j) { f0[j] *= r * qhn[sub * 8 + j]; f1[j] *= r * qhn[64 + sub * 8 + j]; f2[j] *= r * qhn[128 + sub * 8 + j]; }
            float o2[8];
#pragma unroll
            for (int j = 0; j < 8; ++j) { const float other = __shfl_xor(f2[j], 4); const float c = rp[ri + j], s = rp[32 + ri + j];
                o2[j] = (sub < 4) ? (f2[j] * c - other * s) : (other * s + f2[j] * c); }
            *(u32x4*)(qrow + sub * 8) = pack8(f0); *(u32x4*)(qrow + 64 + sub * 8) = pack8(f1); *(u32x4*)(qrow + 128 + sub * 8) = pack8(o2);
        }
        {
            const bf16_t* kvrow = kv + (size_t)t * 2048 + head * 256;
            float f0[8], f1[8], f2[8];
            unpack8(*(const u32x4*)(kvrow + sub * 8), f0); unpack8(*(const u32x4*)(kvrow + 64 + sub * 8), f1); unpack8(*(const u32x4*)(kr + (size_t)t * 64 + sub * 8), f2);
            float ss = 0.f;
#pragma unroll
            for (int j = 0; j < 8; ++j) ss += f0[j] * f0[j] + f1[j] * f1[j] + f2[j] * f2[j];
            ss += __shfl_xor(ss, 1); ss += __shfl_xor(ss, 2); ss += __shfl_xor(ss, 4);
            const float r = rsqrtf(ss * (1.0f / 192) + 1e-6f);
#pragma unroll
            for (int j = 0; j < 8; ++j) { f0[j] *= r * khn[sub * 8 + j]; f1[j] *= r * khn[64 + sub * 8 + j]; f2[j] *= r * khn[128 + sub * 8 + j]; }
            float o2[8];
#pragma unroll
            for (int j = 0; j < 8; ++j) { const float other = __shfl_xor(f2[j], 4); const float c = rp[ri + j], s = rp[32 + ri + j];
                o2[j] = (sub < 4) ? (f2[j] * c - other * s) : (other * s + f2[j] * c); }
            bf16_t* krow = Km + (size_t)t * 1536 + head * 192;
            *(u32x4*)(krow + sub * 8) = pack8(f0); *(u32x4*)(krow + 64 + sub * 8) = pack8(f1); *(u32x4*)(krow + 128 + sub * 8) = pack8(o2);
        }
#pragma unroll
        for (int q = 0; q < 2; ++q) {
            const int c = (lane + 64 * q) * 8; const size_t o = (size_t)t * 1024 + c;
            float kbv[8], wl[8], al[8], dec[8], khv[8], nav[8], bbv[8];
            unpack8(*(const u32x4*)(kb + o), kbv); unpack8(*(const u32x4*)(lout + (size_t)t * 3072 + c), wl); unpack8(*(const u32x4*)(lout + (size_t)t * 3072 + 1024 + c), al);
            float nn = 0.f;
#pragma unroll
            for (int j = 0; j < 8; ++j) {
                const float x = -(w0[c + j] + wl[j]);
                const float sp = (x > 20.f) ? x : __logf(1.0f + __expf(x));
                dec[j] = __expf(-__expf(-sp - 0.5f));
                al[j] = sigmoidf_(a0[c + j] + al[j]);
                wl[j] = kbv[j] * k_k[c + j]; nn += wl[j] * wl[j];
            }
            nn += __shfl_xor(nn, 1); nn += __shfl_xor(nn, 2); nn += __shfl_xor(nn, 4);
            const float rn = __builtin_amdgcn_rcpf(fmaxf(__builtin_amdgcn_sqrtf(nn), 1e-12f));
#pragma unroll
            for (int j = 0; j < 8; ++j) { const float kk = wl[j] * rn; khv[j] = kbv[j] * (1.0f + (al[j] - 1.0f) * k_a[c + j]); nav[j] = -kk; bbv[j] = kk * al[j]; }
            *(f32x4*)(decay + o) = (f32x4){dec[0], dec[1], dec[2], dec[3]}; *(f32x4*)(decay + o + 4) = (f32x4){dec[4], dec[5], dec[6], dec[7]};
            *(u32x4*)(kh + o) = pack8(khv); *(u32x4*)(na + o) = pack8(nav); *(u32x4*)(bb + o) = pack8(bbv);
        }
    }
}

template <int DQK> struct AttnCfg { static constexpr int KSTR = DQK * 2 + 16, VSTR = 320, KB = 64 * KSTR, VB = 64 * VSTR, VOFF = 2 * KB, NKC = DQK / 64; };
template <int DQK, int MODE>
DEVI void attn_item(LAS unsigned char* lds, const bf16_t* Qh, int qs, const bf16_t* Kh, int ks_, const bf16_t* Vh, int vs, bf16_t* Oh, int os,
                    float* lse, int lses, int i0, int dil, int res) {
    typedef AttnCfg<DQK> C;
    const int tid = otid(), wave = tid >> 6, lane = tid & 63, l31 = lane & 31, hh = lane >> 5;
    const bool grpB = __builtin_amdgcn_readfirstlane(wave) >= 4;
    const int qidx = i0 + 32 * wave + l31;
    bf16x8 qf[DQK / 16];
    { const bf16_t* qrow = Qh + (size_t)(res + dil * qidx) * qs;
#pragma unroll
      for (int k = 0; k < DQK / 16; ++k) qf[k] = *(const bf16x8*)(qrow + 16 * k + 8 * hh);
#pragma unroll
      for (int k = 0; k < DQK / 16; ++k) asm volatile("" : "+v"(qf[k]));
    }
    const int kbase = MODE ? (i0 - 128) : 0;
    const int j0 = (MODE && kbase < 0) ? 2 : 0;
    const int j1 = MODE ? 6 : (i0 / 64 + 4);
    f32x16 O[4];
#pragma unroll
    for (int c = 0; c < 4; ++c)
#pragma unroll
        for (int j = 0; j < 16; ++j) O[c][j] = 0.f;
    float mrun = -1e30f, lrun = 0.f;
    u32x4 kreg[C::NKC], vreg[2];
    u32x4 pk[4];
#pragma unroll
    for (int i = 0; i < 4; ++i) pk[i] = (u32x4){0u, 0u, 0u, 0u};
    auto gload = [&](int jt) {
        const int kb0 = kbase + 64 * jt;
#pragma unroll
        for (int u = 0; u < C::NKC; ++u) { const int id = tid + NT * u, row = id / (DQK / 8), cc = id % (DQK / 8);
            kreg[u] = *(const u32x4*)(Kh + (size_t)(res + dil * (kb0 + row)) * ks_ + cc * 8); }
#pragma unroll
        for (int u = 0; u < 2; ++u) { const int id = tid + NT * u, row = id >> 4, cc = id & 15;
            vreg[u] = *(const u32x4*)(Vh + (size_t)(res + dil * (kb0 + row)) * vs + cc * 8); }
    };
    auto lstore = [&](int kbi, int vbi) {
        LAS unsigned char* kb_ = lds + kbi * C::KB; LAS unsigned char* vb_ = lds + C::VOFF + vbi * C::VB;
#pragma unroll
        for (int u = 0; u < C::NKC; ++u) { const int id = tid + NT * u, row = id / (DQK / 8), cc = id % (DQK / 8);
            *(LAS u32x4*)(kb_ + row * C::KSTR + cc * 16) = kreg[u]; }
#pragma unroll
        for (int u = 0; u < 2; ++u) { const int id = tid + NT * u, row = id >> 4, cc = id & 15;
            *(LAS u32x4*)(vb_ + row * C::VSTR + cc * 16) = vreg[u]; }
    };
    const int vq = (lane & 15) >> 2, vp = lane & 3, vblk = (lane >> 4) & 1;
    auto pv = [&](int vbi) {
        const LAS unsigned char* vbuf = lds + C::VOFF + vbi * C::VB + (4 * hh + vq) * C::VSTR + (16 * vblk + 4 * vp) * 2;
        auto vld = [&](int i) {
            const int sl = i >> 2, c = i & 3;
            const LAS unsigned char* a = vbuf + (32 * (sl >> 1) + 16 * (sl & 1)) * C::VSTR + 64 * c;
            const s16x4 t0 = __builtin_amdgcn_ds_read_tr16_b64_v4i16((LAS s16x4*)a);
            const s16x4 t1 = __builtin_amdgcn_ds_read_tr16_b64_v4i16((LAS s16x4*)(a + 8 * C::VSTR));
            bf16x8 vf; vf[0] = t0[0]; vf[1] = t0[1]; vf[2] = t0[2]; vf[3] = t0[3]; vf[4] = t1[0]; vf[5] = t1[1]; vf[6] = t1[2]; vf[7] = t1[3];
            return vf;
        };
        bf16x8 fv[3];
        __builtin_amdgcn_s_setprio(1);
        fv[0] = vld(0); fv[1] = vld(1);
        __builtin_amdgcn_sched_barrier(0);
#pragma unroll
        for (int i = 0; i < 16; ++i) {
            if (i + 2 < 16) fv[(i + 2) % 3] = vld(i + 2);
            __builtin_amdgcn_sched_barrier(0);
            bf16x8 pf; __builtin_memcpy(&pf, &pk[i >> 2], 16);
            O[i & 3] = __builtin_amdgcn_mfma_f32_32x32x16_bf16(fv[i % 3], pf, O[i & 3], 0, 0, 0);
            __builtin_amdgcn_sched_barrier(0);
        }
        __builtin_amdgcn_s_setprio(0);
    };
    gload(j0); lstore(0, 0); __syncthreads();
    const int qw0 = i0 + 32 * wave;
    bool havePrev = false;
    int kbi = 0, vbi = 0;
    for (int jt = j0; jt < j1; ++jt) {
        if (jt + 1 < j1) gload(jt + 1);
        const int vprev = vbi == 0 ? 2 : vbi - 1;
        if (grpB && havePrev) pv(vprev);
        havePrev = false;
        const int kb0 = kbase + 64 * jt;
        bool need = kb0 <= qw0 + 31;
        if (MODE) need = need && (kb0 + 63 >= qw0 - 128);
        if (need) {
            const LAS unsigned char* kbuf = lds + kbi * C::KB;
            f32x16 s0, s1;
#pragma unroll
            for (int j = 0; j < 16; ++j) { s0[j] = 0.f; s1[j] = 0.f; }
            {
                constexpr int NK = DQK / 16;
                const LAS unsigned char* kp0 = kbuf + l31 * C::KSTR + 16 * hh;
                const LAS unsigned char* kp1 = kp0 + 32 * C::KSTR;
                bf16x8 fa[3][2];
                __builtin_amdgcn_s_setprio(1);
#pragma unroll
                for (int k = 0; k < 2; ++k) { fa[k][0] = *(const LAS bf16x8*)(kp0 + 32 * k); fa[k][1] = *(const LAS bf16x8*)(kp1 + 32 * k); }
                __builtin_amdgcn_sched_barrier(0);
#pragma unroll
                for (int k = 0; k < NK; ++k) {
                    if (k + 2 < NK) { fa[(k + 2) % 3][0] = *(const LAS bf16x8*)(kp0 + 32 * (k + 2)); fa[(k + 2) % 3][1] = *(const LAS bf16x8*)(kp1 + 32 * (k + 2)); }
                    __builtin_amdgcn_sched_barrier(0);
                    s0 = __builtin_amdgcn_mfma_f32_32x32x16_bf16(fa[k % 3][0], qf[k], s0, 0, 0, 0);
                    s1 = __builtin_amdgcn_mfma_f32_32x32x16_bf16(fa[k % 3][1], qf[k], s1, 0, 0, 0);
                    __builtin_amdgcn_sched_barrier(0);
                }
                __builtin_amdgcn_s_setprio(0);
            }
            const bool domask = MODE ? !(kb0 + 63 <= qw0 && kb0 >= qw0 + 31 - 128) : (kb0 + 63 > qw0);
            if (domask) {
#pragma unroll
                for (int j = 0; j < 16; ++j) { const int key0 = kb0 + 8 * (j >> 2) + 4 * hh + (j & 3), key1 = key0 + 32;
                    bool v0 = key0 <= qidx, v1 = key1 <= qidx;
                    if (MODE) { v0 = v0 && (key0 >= qidx - 128); v1 = v1 && (key1 >= qidx - 128); }
                    s0[j] = v0 ? s0[j] : -1e30f; s1[j] = v1 ? s1[j] : -1e30f; }
            }
            float mx = s0[0];
#pragma unroll
            for (int j = 0; j < 16; ++j) asm("v_max3_f32 %0, %0, %1, %2" : "+v"(mx) : "v"(s0[j]), "v"(s1[j]));
            { const u32x2 sw = __builtin_amdgcn_permlane32_swap(__float_as_uint(mx), __float_as_uint(mx), false, false);
              mx = fmaxf(__uint_as_float(sw[0]), __uint_as_float(sw[1])); }
            const float mnew = fmaxf(mrun, mx);
            const float alpha = __builtin_amdgcn_exp2f(mrun - mnew);
            mrun = mnew;
            const float msafe = fmaxf(mnew, -1e29f);
            float ls = 0.f;
#pragma unroll
            for (int j = 0; j < 16; ++j) { const float p0 = __builtin_amdgcn_exp2f(s0[j] - msafe), p1 = __builtin_amdgcn_exp2f(s1[j] - msafe);
                s0[j] = p0; s1[j] = p1; ls += p0 + p1; }
            lrun = lrun * alpha + ls;
#pragma unroll
            for (int c = 0; c < 4; ++c)
#pragma unroll
                for (int j = 0; j < 16; ++j) O[c][j] *= alpha;
            pk[0] = (u32x4){pk_bf16(s0[0], s0[1]), pk_bf16(s0[2], s0[3]), pk_bf16(s0[4], s0[5]), pk_bf16(s0[6], s0[7])};
            pk[1] = (u32x4){pk_bf16(s0[8], s0[9]), pk_bf16(s0[10], s0[11]), pk_bf16(s0[12], s0[13]), pk_bf16(s0[14], s0[15])};
            pk[2] = (u32x4){pk_bf16(s1[0], s1[1]), pk_bf16(s1[2], s1[3]), pk_bf16(s1[4], s1[5]), pk_bf16(s1[6], s1[7])};
            pk[3] = (u32x4){pk_bf16(s1[8], s1[9]), pk_bf16(s1[10], s1[11]), pk_bf16(s1[12], s1[13]), pk_bf16(s1[14], s1[15])};
            if (!grpB) pv(vbi); else havePrev = true;
        }
        const int kn = kbi ^ 1, vn = vbi == 2 ? 0 : vbi + 1;
        if (jt + 1 < j1) lstore(kn, vn);
        __syncthreads();
        kbi = kn; vbi = vn;
    }
    if (grpB && havePrev) pv(vbi == 0 ? 2 : vbi - 1);
    const float ltot = lrun + __shfl_xor(lrun, 32);
    const float inv = __builtin_amdgcn_rcpf(ltot);
    bf16_t* orow = Oh + (size_t)(res + dil * qidx) * os;
#pragma unroll
    for (int c = 0; c < 4; ++c)
#pragma unroll
        for (int g = 0; g < 4; ++g) { u32x2 w; w.x = pk_bf16(O[c][4 * g] * inv, O[c][4 * g + 1] * inv); w.y = pk_bf16(O[c][4 * g + 2] * inv, O[c][4 * g + 3] * inv);
            *(u32x2*)(orow + 32 * c + 8 * g + 4 * hh) = w; }
    if (lse != nullptr && hh == 0) lse[(size_t)(res + dil * qidx) * lses] = mrun + __builtin_amdgcn_logf(ltot);
}

DEVI float dpp_xor1(float v) { return __int_as_float(__builtin_amdgcn_update_dpp(0, __float_as_int(v), 0xB1, 0xF, 0xF, false)); }
DEVI float dpp_xor2(float v) { return __int_as_float(__builtin_amdgcn_update_dpp(0, __float_as_int(v), 0x4E, 0xF, 0xF, false)); }
constexpr int RW_L = 256, RW_NC = S / RW_L, RW_T = 16, RW_STEPB = 6 * 64 * 4, RW_STAGEB = RW_T * RW_STEPB;
struct RwRegs { f32x4 w0, w1; u32x4 a, b, k, r, v; };
DEVI void rw_gload(RwRegs& R, const Params& P, int head, int t0, int p) {
    unsigned char* ws = P.ws;
    const size_t o = (size_t)(t0 + (p >> 3)) * 1024 + head * 64 + (p & 7) * 8;
    R.w0 = *(const f32x4*)((const float*)(ws + E_DECAY) + o); R.w1 = *(const f32x4*)((const float*)(ws + E_DECAY) + o + 4);
    R.a = *(const u32x4*)((const bf16_t*)(ws + E_NA) + o); R.b = *(const u32x4*)((const bf16_t*)(ws + E_BB) + o);
    R.k = *(const u32x4*)((const bf16_t*)(ws + E_KH) + o); R.r = *(const u32x4*)((const bf16_t*)(ws + E_R) + o); R.v = *(const u32x4*)((const bf16_t*)(ws + E_V) + o);
}
DEVI void rw_st8(LAS unsigned char* d, u32x4 u) { float f[8]; unpack8(u, f); *(LAS f32x4*)d = (f32x4){f[0], f[1], f[2], f[3]}; *(LAS f32x4*)(d + 16) = (f32x4){f[4], f[5], f[6], f[7]}; }
DEVI void rw_lstore(const RwRegs& R, LAS unsigned char* buf, int p) {
    LAS unsigned char* dst = buf + (p >> 3) * RW_STEPB + (p & 7) * 32;
    *(LAS f32x4*)(dst) = R.w0; *(LAS f32x4*)(dst + 16) = R.w1;
    rw_st8(dst + 256, R.a); rw_st8(dst + 512, R.b); rw_st8(dst + 768, R.k); rw_st8(dst + 1024, R.r); rw_st8(dst + 1280, R.v);
}
DEVI void rwkv_A(LAS unsigned char* lds, const Params& P) {
    const int tid = otid(), inst = tid >> 7, p = tid & 127, rp = p >> 2, qc = p & 3;
    float* pu = (float*)(P.ws + E_PU);
    for (int it0 = obid() * 4; it0 < 16 * RW_NC; it0 += gridDim.x * 4) {
        const int item = it0 + inst, head = item / RW_NC, chunk = item % RW_NC, tb = chunk * RW_L;
        f32x2 Pm[2][8], Um[2][8];
#pragma unroll
        for (int h = 0; h < 2; ++h)
#pragma unroll
            for (int j = 0; j < 8; ++j) { Pm[h][j] = (f32x2){(16 * qc + 2 * j == 2 * rp + h) ? 1.f : 0.f, (16 * qc + 2 * j + 1 == 2 * rp + h) ? 1.f : 0.f}; Um[h][j] = (f32x2){0.f, 0.f}; }
        LAS unsigned char* buf = lds + inst * RW_STAGEB;
        RwRegs R; rw_gload(R, P, head, tb, p);
        for (int st = 0; st < RW_L / RW_T; ++st) {
            rw_lstore(R, buf, p);
            __syncthreads();
            if (st + 1 < RW_L / RW_T) rw_gload(R, P, head, tb + (st + 1) * RW_T, p);
            const LAS unsigned char* sb = buf + qc * 64;
#pragma unroll 2
            for (int s = 0; s < RW_T; ++s) {
                const LAS unsigned char* sp = sb + s * RW_STEPB;
                f32x2 w[8], a[8], b[8], k[8];
#pragma unroll
                for (int q = 0; q < 4; ++q) {
                    const f32x4 tw = *(const LAS f32x4*)(sp + q * 16), ta = *(const LAS f32x4*)(sp + 256 + q * 16), tb_ = *(const LAS f32x4*)(sp + 512 + q * 16), tk = *(const LAS f32x4*)(sp + 768 + q * 16);
                    w[2 * q] = (f32x2){tw[0], tw[1]}; w[2 * q + 1] = (f32x2){tw[2], tw[3]}; a[2 * q] = (f32x2){ta[0], ta[1]}; a[2 * q + 1] = (f32x2){ta[2], ta[3]};
                    b[2 * q] = (f32x2){tb_[0], tb_[1]}; b[2 * q + 1] = (f32x2){tb_[2], tb_[3]}; k[2 * q] = (f32x2){tk[0], tk[1]}; k[2 * q + 1] = (f32x2){tk[2], tk[3]};
                }
                const LAS float* vp = (const LAS float*)(sp - qc * 64 + 1280 + rp * 8);
                const float vi[2] = {vp[0], vp[1]};
#pragma unroll
                for (int h = 0; h < 2; ++h) {
                    f32x2 ap = {0.f, 0.f}, au = {0.f, 0.f};
#pragma unroll
                    for (int j = 0; j < 8; ++j) { ap = __builtin_elementwise_fma(Pm[h][j], a[j], ap); au = __builtin_elementwise_fma(Um[h][j], a[j], au); }
                    float sp_ = ap[0] + ap[1], su = au[0] + au[1];
                    sp_ += dpp_xor1(sp_); su += dpp_xor1(su); sp_ += dpp_xor2(sp_); su += dpp_xor2(su);
                    const f32x2 sp2 = {sp_, sp_}, su2 = {su, su}, v2 = {vi[h], vi[h]};
#pragma unroll
                    for (int j = 0; j < 8; ++j) { Pm[h][j] = __builtin_elementwise_fma(Pm[h][j], w[j], sp2 * b[j]);
                        Um[h][j] = __builtin_elementwise_fma(Um[h][j], w[j], __builtin_elementwise_fma(su2, b[j], v2 * k[j])); }
                }
            }
            __syncthreads();
        }
#pragma unroll
        for (int h = 0; h < 2; ++h) {
            float* po = pu + ((size_t)item * 2) * 4096 + (2 * rp + h) * 64 + qc * 16;
#pragma unroll
            for (int q = 0; q < 4; ++q) { *(f32x4*)(po + q * 4) = (f32x4){Pm[h][2 * q][0], Pm[h][2 * q][1], Pm[h][2 * q + 1][0], Pm[h][2 * q + 1][1]};
                *(f32x4*)(po + 4096 + q * 4) = (f32x4){Um[h][2 * q][0], Um[h][2 * q][1], Um[h][2 * q + 1][0], Um[h][2 * q + 1][1]}; }
        }
    }
}
DEVI void rwkv_B(LAS unsigned char* lds, const Params& P, int head) {
    const int tid = otid(), i = tid >> 3, jg = tid & 7;
    const float* pu = (const float*)(P.ws + E_PU); float* sin = (float*)(P.ws + E_SIN);
    LAS float* Sl = (LAS float*)lds;
    LAS float* Pl = (LAS float*)(lds + 64 * 65 * 4);
    float cur[8];
#pragma unroll
    for (int e = 0; e < 8; ++e) { cur[e] = 0.f; Sl[i * 65 + 8 * jg + e] = 0.f; }
    for (int c = 0; c < RW_NC; ++c) {
        const size_t item = (size_t)head * RW_NC + c;
        float* so = sin + item * 4096 + i * 64 + 8 * jg;
        *(f32x4*)so = (f32x4){cur[0], cur[1], cur[2], cur[3]}; *(f32x4*)(so + 4) = (f32x4){cur[4], cur[5], cur[6], cur[7]};
        const float* pc = pu + item * 2 * 4096;
#pragma unroll
        for (int u = 0; u < 2; ++u) { const int id = tid + NT * u; *(LAS f32x4*)(Pl + id * 4) = *(const f32x4*)(pc + id * 4); }
        const f32x4 u0 = *(const f32x4*)(pc + 4096 + i * 64 + 8 * jg), u1 = *(const f32x4*)(pc + 4096 + i * 64 + 8 * jg + 4);
        float acc[8] = {u0[0], u0[1], u0[2], u0[3], u1[0], u1[1], u1[2], u1[3]};
        __syncthreads();
#pragma unroll 8
        for (int k = 0; k < 64; ++k) { const float s = Sl[i * 65 + k]; const f32x4 p0 = *(const LAS f32x4*)(Pl + k * 64 + 8 * jg), p1 = *(const LAS f32x4*)(Pl + k * 64 + 8 * jg + 4);
            acc[0] += s * p0[0]; acc[1] += s * p0[1]; acc[2] += s * p0[2]; acc[3] += s * p0[3]; acc[4] += s * p1[0]; acc[5] += s * p1[1]; acc[6] += s * p1[2]; acc[7] += s * p1[3]; }
        __syncthreads();
#pragma unroll
        for (int e = 0; e < 8; ++e) { cur[e] = acc[e]; Sl[i * 65 + 8 * jg + e] = acc[e]; }
        __syncthreads();
    }
}
DEVI void rwkv_C(LAS unsigned char* lds, const Params& P) {
    const int tid = otid(), inst = tid >> 7, p = tid & 127, rp = p >> 2, qc = p & 3;
    const float* sin = (const float*)(P.ws + E_SIN); bf16_t* y = (bf16_t*)(P.ws + E_Y);
    for (int it0 = obid() * 4; it0 < 16 * RW_NC; it0 += gridDim.x * 4) {
        const int item = it0 + inst, head = item / RW_NC, chunk = item % RW_NC, tb = chunk * RW_L;
        f32x2 St[2][8];
#pragma unroll
        for (int h = 0; h < 2; ++h) { const float* si = sin + (size_t)item * 4096 + (2 * rp + h) * 64 + qc * 16;
#pragma unroll
          for (int q = 0; q < 4; ++q) { const f32x4 x = *(const f32x4*)(si + q * 4); St[h][2 * q] = (f32x2){x[0], x[1]}; St[h][2 * q + 1] = (f32x2){x[2], x[3]}; } }
        LAS unsigned char* buf = lds + inst * RW_STAGEB;
        LAS float* yb = (LAS float*)(lds + 4 * RW_STAGEB + inst * RW_T * 256);
        RwRegs R; rw_gload(R, P, head, tb, p);
        for (int st = 0; st < RW_L / RW_T; ++st) {
            rw_lstore(R, buf, p);
            __syncthreads();
            if (st + 1 < RW_L / RW_T) rw_gload(R, P, head, tb + (st + 1) * RW_T, p);
            const LAS unsigned char* sb = buf + qc * 64;
#pragma unroll 2
            for (int s = 0; s < RW_T; ++s) {
                const LAS unsigned char* sp = sb + s * RW_STEPB;
                f32x2 w[8], a[8], b[8], k[8], r[8];
#pragma unroll
                for (int q = 0; q < 4; ++q) {
                    const f32x4 tw = *(const LAS f32x4*)(sp + q * 16), ta = *(const LAS f32x4*)(sp + 256 + q * 16), tb_ = *(const LAS f32x4*)(sp + 512 + q * 16),
                                tk = *(const LAS f32x4*)(sp + 768 + q * 16), tr = *(const LAS f32x4*)(sp + 1024 + q * 16);
                    w[2 * q] = (f32x2){tw[0], tw[1]}; w[2 * q + 1] = (f32x2){tw[2], tw[3]}; a[2 * q] = (f32x2){ta[0], ta[1]}; a[2 * q + 1] = (f32x2){ta[2], ta[3]};
                    b[2 * q] = (f32x2){tb_[0], tb_[1]}; b[2 * q + 1] = (f32x2){tb_[2], tb_[3]}; k[2 * q] = (f32x2){tk[0], tk[1]}; k[2 * q + 1] = (f32x2){tk[2], tk[3]};
                    r[2 * q] = (f32x2){tr[0], tr[1]}; r[2 * q + 1] = (f32x2){tr[2], tr[3]};
                }
                const LAS float* vp = (const LAS float*)(sp - qc * 64 + 1280 + rp * 8);
                const float vi[2] = {vp[0], vp[1]};
                float yy[2];
#pragma unroll
                for (int h = 0; h < 2; ++h) {
                    f32x2 as = {0.f, 0.f};
#pragma unroll
                    for (int j = 0; j < 8; ++j) as = __builtin_elementwise_fma(St[h][j], a[j], as);
                    float sa = as[0] + as[1];
                    sa += dpp_xor1(sa); sa += dpp_xor2(sa);
                    const f32x2 sa2 = {sa, sa}, v2 = {vi[h], vi[h]};
                    f32x2 ay = {0.f, 0.f};
#pragma unroll
                    for (int j = 0; j < 8; ++j) { St[h][j] = __builtin_elementwise_fma(St[h][j], w[j], __builtin_elementwise_fma(sa2, b[j], v2 * k[j])); ay = __builtin_elementwise_fma(St[h][j], r[j], ay); }
                    float t_ = ay[0] + ay[1];
                    t_ += dpp_xor1(t_); t_ += dpp_xor2(t_);
                    yy[h] = t_;
                }
                if (qc == 0) { yb[s * 64 + 2 * rp] = yy[0]; yb[s * 64 + 2 * rp + 1] = yy[1]; }
            }
            __syncthreads();
            { const LAS float* ys = yb + (p >> 3) * 64 + (p & 7) * 8; float f[8];
#pragma unroll
              for (int j = 0; j < 8; ++j) f[j] = ys[j];
              *(u32x4*)(y + (size_t)(tb + st * RW_T + (p >> 3)) * 1024 + head * 64 + (p & 7) * 8) = pack8(f); }
        }
    }
}

DEVI void emix(LAS unsigned char* lds, const Params& P) {
    unsigned char* ws = P.ws;
    if (obid() < 16) { rwkv_B(lds, P, obid()); }
    unsigned* cnt = (unsigned*)(ws + OFF_CNT) + 32;
    LAS int* slot = (LAS int*)(lds + LDS_BYTES - 16);
    const bf16_t* Q = (const bf16_t*)(ws + E_Q); const bf16_t* Km = (const bf16_t*)(ws + E_K); const bf16_t* kv = (const bf16_t*)(ws + E_KV);
    bf16_t* mix = (bf16_t*)(ws + OFF_XN);
    const int xcd = (int)(xb_xcc_id() & 7u);
    for (;;) {
        if (otid() == 0) { int hsel = -1, nsel = 0;
            for (int k = 0; k < 8; ++k) { const int h = (xcd + k) & 7; const int n = (int)atomicAdd(cnt + h, 1u); if (n < 64) { hsel = h; nsel = n; break; } }
            slot[0] = hsel; slot[1] = nsel; }
        __syncthreads();
        const int head = slot[0], n = slot[1];
        __syncthreads();
        if (head < 0) break;
        const int qb = 63 - n;
        attn_item<192, 0>(lds, Q + head * 192, 1536, Km + head * 192, 1536, kv + head * 256 + 128, 2048, mix + head * 128, 2048, nullptr, 0, qb * 256, 1, 0);
    }
}

DEVI void epost(const Params& P) {
    unsigned char* ws = P.ws;
    const bf16_t* y = (const bf16_t*)(ws + E_Y); const bf16_t* rr = (const bf16_t*)(ws + E_R); const bf16_t* kh = (const bf16_t*)(ws + E_KH); const bf16_t* vv = (const bf16_t*)(ws + E_V);
    const bf16_t* lout = (const bf16_t*)(ws + E_LOUT); bf16_t* mix = (bf16_t*)(ws + OFF_XN);
    const float* r_k = P.in[22]; const float* ln_w = P.in[23]; const float* ln_b = P.in[24];
    const int wave = otid() >> 6, lane = otid() & 63;
    for (int t = obid() * 8 + wave; t < S; t += gridDim.x * 8) {
#pragma unroll
        for (int q = 0; q < 2; ++q) {
            const int c = (lane + 64 * q) * 8; const size_t o = (size_t)t * 1024 + c;
            float yv[8], rv[8], kv_[8], v[8], g[8], ov[8];
            unpack8(*(const u32x4*)(y + o), yv); unpack8(*(const u32x4*)(rr + o), rv); unpack8(*(const u32x4*)(kh + o), kv_); unpack8(*(const u32x4*)(vv + o), v);
            unpack8(*(const u32x4*)(lout + (size_t)t * 3072 + 2048 + c), g);
            float s1 = 0.f, s3 = 0.f;
#pragma unroll
            for (int j = 0; j < 8; ++j) { s1 += yv[j]; s3 += rv[j] * kv_[j] * r_k[c + j]; }
            s1 += __shfl_xor(s1, 1); s3 += __shfl_xor(s3, 1); s1 += __shfl_xor(s1, 2); s3 += __shfl_xor(s3, 2); s1 += __shfl_xor(s1, 4); s3 += __shfl_xor(s3, 4);
            const float mean = s1 * (1.0f / 64);
            float s2 = 0.f;
#pragma unroll
            for (int j = 0; j < 8; ++j) { yv[j] -= mean; s2 += yv[j] * yv[j]; }
            s2 += __shfl_xor(s2, 1); s2 += __shfl_xor(s2, 2); s2 += __shfl_xor(s2, 4);
            const float rs = rsqrtf(s2 * (1.0f / 64) + 64e-5f);
#pragma unroll
            for (int j = 0; j < 8; ++j) ov[j] = ((yv[j] * rs * ln_w[c + j] + ln_b[c + j]) + s3 * v[j]) * g[j];
            *(u32x4*)(mix + (size_t)t * 2048 + 1024 + c) = pack8(ov);
        }
    }
}

DEVI void oprep(const Params& P) {
    unsigned char* ws = P.ws;
    bf16_t* p = (bf16_t*)(ws + O_P); float* lg = (float*)(ws + O_LG);
    const float* rope = (const float*)(ws + OFF_ROPE128);
    const float* qhn = P.in[27]; const float* khn = P.in[28]; const float* wgu = P.in[29]; const float* bg = P.in[30];
    const int wave = otid() >> 6, lane = otid() & 63, head = lane >> 3, sub = lane & 7;
    const float qscale = 0.08838834764831845f * 1.4426950408889634f;
    for (int t = obid() * 8 + wave; t < S; t += gridDim.x * 8) {
        bf16_t* row = p + (size_t)t * ODD_LD;
        const float* rp = rope + (size_t)t * 128;
#pragma unroll
        for (int which = 0; which < 2; ++which) {
            bf16_t* hrow = row + which * 1024 + head * 128;
            const float* nw = which ? khn : qhn;
            float f0[8], f1[8], o0[8], o1[8];
            unpack8(*(const u32x4*)(hrow + sub * 8), f0); unpack8(*(const u32x4*)(hrow + 64 + sub * 8), f1);
            float ss = 0.f;
#pragma unroll
            for (int j = 0; j < 8; ++j) ss += f0[j] * f0[j] + f1[j] * f1[j];
            ss += __shfl_xor(ss, 1); ss += __shfl_xor(ss, 2); ss += __shfl_xor(ss, 4);
            const float r = rsqrtf(ss * (1.0f / 128) + 1e-6f) * (which ? 1.0f : qscale);
#pragma unroll
            for (int j = 0; j < 8; ++j) { const float x1 = f0[j] * r * nw[sub * 8 + j], x2 = f1[j] * r * nw[64 + sub * 8 + j];
                const float c = rp[sub * 8 + j], s = rp[64 + sub * 8 + j];
                o0[j] = x1 * c - x2 * s; o1[j] = x1 * s + x2 * c; }
            *(u32x4*)(hrow + sub * 8) = pack8(o0); *(u32x4*)(hrow + 64 + sub * 8) = pack8(o1);
        }
        float gl[16];
        { float a[8], b[8]; unpack8(*(const u32x4*)(row + 5120), a); unpack8(*(const u32x4*)(row + 5128), b);
#pragma unroll
          for (int j = 0; j < 8; ++j) { gl[j] = a[j]; gl[8 + j] = b[j]; } }
#pragma unroll
        for (int q = 0; q < 2; ++q) {
            const int c0 = (lane + 64 * q) * 4;
            f32x4 acc = *(const f32x4*)(bg + c0);
#pragma unroll
            for (int j = 0; j < 16; ++j) { const f32x4 w = *(const f32x4*)(wgu + j * 512 + c0); acc += w * gl[j]; }
            f32x4 o;
#pragma unroll
            for (int e = 0; e < 4; ++e) { const float x = acc[e]; const float ls = fminf(x, 0.f) - __logf(1.0f + __expf(-fabsf(x))); o[e] = ls * (1.0f / 16); }
            *(f32x4*)(lg + (size_t)t * 512 + c0) = o;
        }
    }
}

DEVI bf16x8 frag_rm(const LAS unsigned char* base, int ld, int m0, int k0, int lane) {
    return *(const LAS bf16x8*)(base + (m0 + (lane & 31)) * ld + (k0 + 8 * (lane >> 5)) * 2);
}
DEVI bf16x8 frag_tr(const LAS unsigned char* base, int ld, int k0, int m0, int lane) {
    const int h = lane >> 5, blk = (lane >> 4) & 1, q = (lane & 15) >> 2, p = lane & 3;
    const LAS unsigned char* a = base + (k0 + 8 * h + q) * ld + (m0 + 16 * blk + 4 * p) * 2;
    const s16x4 t0 = __builtin_amdgcn_ds_read_tr16_b64_v4i16((LAS s16x4*)a);
    const s16x4 t1 = __builtin_amdgcn_ds_read_tr16_b64_v4i16((LAS s16x4*)(a + 4 * ld));
    bf16x8 v; v[0] = t0[0]; v[1] = t0[1]; v[2] = t0[2]; v[3] = t0[3]; v[4] = t1[0]; v[5] = t1[1]; v[6] = t1[2]; v[7] = t1[3];
    return v;
}

constexpr int G_QS = 0, G_KS = 17408, G_VS = 34816, G_SS = 68608, G_AS = 136192;
constexpr int G_LDQ = 272, G_LDV = 528, G_LDA = 144;
DEVI void gla_bcum(LAS unsigned char* lds, const float* lg, int chunk, int head) {
    LAS float* L = (LAS float*)(lds + G_SS);
    const int tid = otid();
#pragma unroll
    for (int u = 0; u < 4; ++u) { const int id = tid + NT * u, row = id >> 5, c4 = id & 31;
        *(LAS f32x4*)(L + row * 128 + c4 * 4) = *(const f32x4*)(lg + (size_t)(chunk * 64 + row) * 512 + head * 128 + c4 * 4); }
    __syncthreads();
    if (tid < 128) { float run = 0.f;
        for (int s = 0; s < 64; ++s) { run += L[s * 128 + tid]; L[s * 128 + tid] = run; } }
    __syncthreads();
}
DEVI void gla_load_v(LAS unsigned char* lds, const bf16_t* p, int chunk, int head) {
    const int tid = otid();
#pragma unroll
    for (int u = 0; u < 4; ++u) { const int id = tid + NT * u, row = id >> 5, cc = id & 31;
        *(LAS u32x4*)(lds + G_VS + row * G_LDV + cc * 16) = *(const u32x4*)(p + (size_t)(chunk * 64 + row) * ODD_LD + 4096 + head * 256 + cc * 8); }
}
DEVI void gla_local(LAS unsigned char* lds, const Params& P, int item) {
    unsigned char* ws = P.ws;
    const bf16_t* p = (const bf16_t*)(ws + O_P); const float* lg = (const float*)(ws + O_LG);
    float* ust = (float*)(ws + O_UST); float* dvec = (float*)(ws + O_DVEC);
    const int chunk = item >> 2, head = item & 3, tid = otid(), wave = tid >> 6, lane = tid & 63;
    gla_bcum(lds, lg, chunk, head);
    const LAS float* L = (const LAS float*)(lds + G_SS);
    gla_load_v(lds, p, chunk, head);
#pragma unroll
    for (int u = 0; u < 2; ++u) { const int id = tid + NT * u, row = id >> 4, cc = id & 15;
        float f[8]; unpack8(*(const u32x4*)(p + (size_t)(chunk * 64 + row) * ODD_LD + 3584 + head * 128 + cc * 8), f);
#pragma unroll
        for (int j = 0; j < 8; ++j) f[j] *= __expf(L[63 * 128 + cc * 8 + j] - L[row * 128 + cc * 8 + j]);
        *(LAS u32x4*)(lds + G_KS + row * G_LDQ + cc * 16) = pack8(f); }
    if (tid < 128) dvec[(size_t)item * 128 + tid] = __expf(L[63 * 128 + tid]);
    __syncthreads();
    const int mt = wave & 3, nb = (wave >> 2) * 4;
    f32x16 acc[4];
#pragma unroll
    for (int n = 0; n < 4; ++n)
#pragma unroll
        for (int j = 0; j < 16; ++j) acc[n][j] = 0.f;
    {
        bf16x8 fa[2], fb[2][4];
        fa[0] = frag_tr(lds + G_KS, G_LDQ, 0, 32 * mt, lane);
#pragma unroll
        for (int n = 0; n < 4; ++n) fb[0][n] = frag_tr(lds + G_VS, G_LDV, 0, 32 * (nb + n), lane);
        __builtin_amdgcn_sched_barrier(0);
#pragma unroll
        for (int ks = 0; ks < 4; ++ks) {
            if (ks + 1 < 4) { fa[(ks + 1) & 1] = frag_tr(lds + G_KS, G_LDQ, 16 * (ks + 1), 32 * mt, lane);
#pragma unroll
                for (int n = 0; n < 4; ++n) fb[(ks + 1) & 1][n] = frag_tr(lds + G_VS, G_LDV, 16 * (ks + 1), 32 * (nb + n), lane); }
            __builtin_amdgcn_sched_barrier(0);
#pragma unroll
            for (int n = 0; n < 4; ++n) acc[n] = __builtin_amdgcn_mfma_f32_32x32x16_bf16(fa[ks & 1], fb[ks & 1][n], acc[n], 0, 0, 0);
            __builtin_amdgcn_sched_barrier(0);
        }
    }
    float* ub = ust + (size_t)item * 128 * 256;
#pragma unroll
    for (int n = 0; n < 4; ++n)
#pragma unroll
        for (int j = 0; j < 16; ++j) { const int k = 32 * mt + 8 * (j >> 2) + 4 * (lane >> 5) + (j & 3), v = 32 * (nb + n) + (lane & 31);
            ub[k * 256 + v] = acc[n][j]; }
    __syncthreads();
}
DEVI void gla_scan(const Params& P) {
    unsigned char* ws = P.ws;
    float* ust = (float*)(ws + O_UST); const float* dvec = (const float*)(ws + O_DVEC);
    const int e = (obid() * NT + otid()) * 4;
    const int dk = (e >> 15) * 128 + ((e >> 8) & 127);
    f32x4 st = {0.f, 0.f, 0.f, 0.f};
    for (int c0 = 0; c0 < 256; c0 += 8) {
        f32x4 u[8]; float d[8];
#pragma unroll
        for (int i = 0; i < 8; ++i) { u[i] = *(const f32x4*)(ust + (size_t)(c0 + i) * 131072 + e); d[i] = dvec[(c0 + i) * 512 + dk]; }
#pragma unroll
        for (int i = 0; i < 8; ++i) { *(f32x4*)(ust + (size_t)(c0 + i) * 131072 + e) = st; st = st * d[i] + u[i]; }
    }
}
DEVI void gla_out(LAS unsigned char* lds, const Params& P, int item) {
    unsigned char* ws = P.ws;
    const bf16_t* p = (const bf16_t*)(ws + O_P); const float* lg = (const float*)(ws + O_LG);
    const float* ust = (const float*)(ws + O_UST); bf16_t* mix = (bf16_t*)(ws + OFF_XN);
    const float* gnorm = P.in[31];
    const int chunk = item >> 2, head = item & 3, tid = otid(), wave = tid >> 6, lane = tid & 63;
    gla_bcum(lds, lg, chunk, head);
    const LAS float* L = (const LAS float*)(lds + G_SS);
    gla_load_v(lds, p, chunk, head);
#pragma unroll
    for (int u = 0; u < 2; ++u) { const int id = tid + NT * u, row = id >> 4, cc = id & 15;
        float fq[8], fk[8];
        unpack8(*(const u32x4*)(p + (size_t)(chunk * 64 + row) * ODD_LD + 3072 + head * 128 + cc * 8), fq);
        unpack8(*(const u32x4*)(p + (size_t)(chunk * 64 + row) * ODD_LD + 3584 + head * 128 + cc * 8), fk);
#pragma unroll
        for (int j = 0; j < 8; ++j) { const float bc = L[row * 128 + cc * 8 + j]; fq[j] *= 0.08838834764831845f * __expf(bc); fk[j] *= __expf(-bc); }
        *(LAS u32x4*)(lds + G_QS + row * G_LDQ + cc * 16) = pack8(fq);
        *(LAS u32x4*)(lds + G_KS + row * G_LDQ + cc * 16) = pack8(fk); }
    __syncthreads();
    {
        const float* sb = ust + (size_t)item * 128 * 256;
#pragma unroll
        for (int u = 0; u < 8; ++u) { const int id = tid + NT * u, row = id >> 5, cc = id & 31;
            const f32x4 a = *(const f32x4*)(sb + row * 256 + cc * 8), b = *(const f32x4*)(sb + row * 256 + cc * 8 + 4);
            u32x4 w; w.x = pk_bf16(a[0], a[1]); w.y = pk_bf16(a[2], a[3]); w.z = pk_bf16(b[0], b[1]); w.w = pk_bf16(b[2], b[3]);
            *(LAS u32x4*)(lds + G_SS + row * G_LDV + cc * 16) = w; }
    }
    if (wave < 4) {
        const int mt = wave >> 1, nt = wave & 1;
        f32x16 acc;
#pragma unroll
        for (int j = 0; j < 16; ++j) acc[j] = 0.f;
        {
            bf16x8 fa[3], fb[3];
#pragma unroll
            for (int ks = 0; ks < 2; ++ks) { fa[ks] = frag_rm(lds + G_QS, G_LDQ, 32 * mt, 16 * ks, lane); fb[ks] = frag_rm(lds + G_KS, G_LDQ, 32 * nt, 16 * ks, lane); }
            __builtin_amdgcn_sched_barrier(0);
#pragma unroll
            for (int ks = 0; ks < 8; ++ks) {
                if (ks + 2 < 8) { fa[(ks + 2) % 3] = frag_rm(lds + G_QS, G_LDQ, 32 * mt, 16 * (ks + 2), lane); fb[(ks + 2) % 3] = frag_rm(lds + G_KS, G_LDQ, 32 * nt, 16 * (ks + 2), lane); }
                __builtin_amdgcn_sched_barrier(0);
                acc = __builtin_amdgcn_mfma_f32_32x32x16_bf16(fa[ks % 3], fb[ks % 3], acc, 0, 0, 0);
                __builtin_amdgcn_sched_barrier(0);
            }
        }
#pragma unroll
        for (int j = 0; j < 16; ++j) { const int tt = 32 * mt + 8 * (j >> 2) + 4 * (lane >> 5) + (j & 3), s = 32 * nt + (lane & 31);
            *(LAS bf16_t*)(lds + G_AS + tt * G_LDA + s * 2) = f2bf(s <= tt ? acc[j] : 0.f); }
    }
    __syncthreads();
    f32x16 o[2];
#pragma unroll
    for (int m = 0; m < 2; ++m)
#pragma unroll
        for (int j = 0; j < 16; ++j) o[m][j] = 0.f;
    {
        bf16x8 fb[2], fa[2][2];
        auto ldstep = [&](int st, bf16x8& b, bf16x8& a0, bf16x8& a1) {
            if (st < 8) { b = frag_tr(lds + G_SS, G_LDV, 16 * st, 32 * wave, lane); a0 = frag_rm(lds + G_QS, G_LDQ, 0, 16 * st, lane); a1 = frag_rm(lds + G_QS, G_LDQ, 32, 16 * st, lane); }
            else { b = frag_tr(lds + G_VS, G_LDV, 16 * (st - 8), 32 * wave, lane); a0 = frag_rm(lds + G_AS, G_LDA, 0, 16 * (st - 8), lane); a1 = frag_rm(lds + G_AS, G_LDA, 32, 16 * (st - 8), lane); }
        };
        ldstep(0, fb[0], fa[0][0], fa[0][1]);
        __builtin_amdgcn_sched_barrier(0);
#pragma unroll
        for (int st = 0; st < 12; ++st) {
            if (st + 1 < 12) ldstep(st + 1, fb[(st + 1) & 1], fa[(st + 1) & 1][0], fa[(st + 1) & 1][1]);
            __builtin_amdgcn_sched_barrier(0);
            o[0] = __builtin_amdgcn_mfma_f32_32x32x16_bf16(fa[st & 1][0], fb[st & 1], o[0], 0, 0, 0);
            o[1] = __builtin_amdgcn_mfma_f32_32x32x16_bf16(fa[st & 1][1], fb[st & 1], o[1], 0, 0, 0);
            __builtin_amdgcn_sched_barrier(0);
        }
    }
    __syncthreads();
    LAS float* Ob = (LAS float*)(lds + G_SS);
#pragma unroll
    for (int m = 0; m < 2; ++m)
#pragma unroll
        for (int j = 0; j < 16; ++j) { const int tt = 32 * m + 8 * (j >> 2) + 4 * (lane >> 5) + (j & 3), v = 32 * wave + (lane & 31); Ob[tt * 260 + v] = o[m][j]; }
    __syncthreads();
    {
        const int row = tid >> 3, sub = tid & 7;
        float vals[32]; float ss = 0.f;
#pragma unroll
        for (int q = 0; q < 8; ++q) { const f32x4 x = *(const LAS f32x4*)(Ob + row * 260 + sub * 32 + q * 4);
#pragma unroll
            for (int e = 0; e < 4; ++e) { vals[q * 4 + e] = x[e]; ss += x[e] * x[e]; } }
        ss += __shfl_xor(ss, 1); ss += __shfl_xor(ss, 2); ss += __shfl_xor(ss, 4);
        const float r = rsqrtf(ss * (1.0f / 256) + 1e-6f);
        const size_t tok = (size_t)(chunk * 64 + row);
        const bf16_t* rd = p + tok * ODD_LD + 5136 + head * 256 + sub * 32;
        bf16_t* mo = mix + tok * 2048 + 1024 + head * 256 + sub * 32;
        const float* gw = gnorm + head * 256 + sub * 32;
        u32x4 gq[4]; f32x4 wq[8];
#pragma unroll
        for (int q = 0; q < 4; ++q) { gq[q] = *(const u32x4*)(rd + q * 8); wq[2 * q] = *(const f32x4*)(gw + q * 8); wq[2 * q + 1] = *(const f32x4*)(gw + q * 8 + 4); }
#pragma unroll
        for (int q = 0; q < 4; ++q) { float g[8], ov[8]; unpack8(gq[q], g);
#pragma unroll
            for (int e = 0; e < 8; ++e) ov[e] = vals[q * 8 + e] * r * wq[2 * q + (e >> 2)][e & 3] * siluf_(g[e]);
            *(u32x4*)(mo + q * 8) = pack8(ov); }
    }
    __syncthreads();
}

DEVI void omerge(const Params& P) {
    unsigned char* ws = P.ws;
    const bf16_t* opat = (const bf16_t*)(ws + O_OPAT); const float* lse = (const float*)(ws + O_LSE); bf16_t* mix = (bf16_t*)(ws + OFF_XN);
    const int wave = otid() >> 6, lane = otid() & 63;
    for (int t = obid() * 8 + wave; t < S; t += gridDim.x * 8) {
#pragma unroll
        for (int q = 0; q < 2; ++q) {
            const int c = (lane + 64 * q) * 8, head = c >> 7;
            const float l0 = lse[(size_t)t * 8 + head], l1 = lse[(SZ + t) * 8 + head], l2 = lse[(2 * SZ + t) * 8 + head];
            const float mx = fmaxf(l0, fmaxf(l1, l2));
            float w0 = __builtin_amdgcn_exp2f(l0 - mx), w1 = __builtin_amdgcn_exp2f(l1 - mx), w2 = __builtin_amdgcn_exp2f(l2 - mx);
            const float inv = __builtin_amdgcn_rcpf(w0 + w1 + w2); w0 *= inv; w1 *= inv; w2 *= inv;
            float a[8], b[8], d[8], o[8];
            unpack8(*(const u32x4*)(opat + (size_t)t * 1024 + c), a); unpack8(*(const u32x4*)(opat + (SZ + t) * 1024 + c), b); unpack8(*(const u32x4*)(opat + (2 * SZ + t) * 1024 + c), d);
#pragma unroll
            for (int e = 0; e < 8; ++e) o[e] = w0 * a[e] + w1 * b[e] + w2 * d[e];
            *(u32x4*)(mix + (size_t)t * 2048 + c) = pack8(o);
        }
    }
}

DEVI void oattn(LAS unsigned char* lds, const Params& P) {
    unsigned char* ws = P.ws;
    if (obid() < 64) gla_scan(P);
    const bf16_t* p = (const bf16_t*)(ws + O_P); bf16_t* opat = (bf16_t*)(ws + O_OPAT); float* lse = (float*)(ws + O_LSE);
    unsigned* cnt = (unsigned*)(ws + OFF_CNT) + 48;
    LAS int* slot = (LAS int*)(lds + LDS_BYTES - 16);
    const int xcd = (int)(xb_xcc_id() & 7u);
    for (;;) {
        if (otid() == 0) { int hsel = -1, nsel = 0;
            for (int k = 0; k < 8; ++k) { const int h = (xcd + k) & 7; const int n = (int)atomicAdd(cnt + h, 1u); if (n < 192) { hsel = h; nsel = n; break; } }
            slot[0] = hsel; slot[1] = nsel; }
        __syncthreads();
        const int head = slot[0], it = slot[1];
        __syncthreads();
        if (head < 0) break;
        const int pat = it >> 6, blk = it & 63;
        const int dil = pat == 0 ? 1 : (pat == 1 ? 4 : 16);
        const int per = 64 / dil;
        const int res = blk / per, i0 = (blk % per) * 256;
        attn_item<128, 1>(lds, p + head * 128, ODD_LD, p + 1024 + head * 128, ODD_LD, p + 2048 + head * 128, ODD_LD,
                          opat + (size_t)pat * SZ * 1024 + head * 128, 1024, lse + (size_t)pat * SZ * 8 + head, 8, i0, dil, res);
    }
}

#define XB_TMO      128
#define XB_XCNT(j)  (256  + 64 * (j))
#define XB_XSUB(j)  (1280 + 64 * (j))
#define XB_XGEN(j)  (2304 + 64 * (j))
#define XB_TOP      3328
#define XB_TOPGEN   3392
#define XCD_BAR_WORDS 3456
#define XB_SPIN_CAP (1u << 20)
DEVI unsigned xb_ld(unsigned* p) { return __hip_atomic_load(p, __ATOMIC_RELAXED, __HIP_MEMORY_SCOPE_AGENT); }
DEVI unsigned xb_add(unsigned* p, unsigned v) { return __hip_atomic_fetch_add(p, v, __ATOMIC_RELAXED, __HIP_MEMORY_SCOPE_AGENT); }
#define XB_SPIN(cond, bar) do { unsigned _sp = 0; while (cond) { __builtin_amdgcn_s_sleep(1); \
    if ((++_sp & 255u) == 0u) { if (xb_ld(&(bar)[XB_TMO])) break; if (_sp > XB_SPIN_CAP) { atomicAdd(&(bar)[XB_TMO], 1u); break; } } } } while (0)
struct XcdBarrier { unsigned* bar; unsigned x; volatile LAS unsigned* st; };
DEVI XcdBarrier xcd_barrier_post(unsigned* bar, volatile LAS unsigned* st) {
    XcdBarrier b; b.bar = bar; b.x = xb_xcc_id(); b.st = st;
    if (otid() == 0) (void)xb_add(&bar[XB_XCNT(b.x)], 1u);
    return b;
}
DEVI void xcd_barrier_complete(unsigned* bar, unsigned x, unsigned& nloc, unsigned& nx) {
    const unsigned G = gridDim.x;
    unsigned sum, cnt, mine, sp = 0u;
    for (;;) {
        sum = 0u; cnt = 0u; mine = 0u;
#pragma unroll
        for (unsigned j = 0; j < 16; ++j) { const unsigned c = xb_ld(&bar[XB_XCNT(j)]); sum += c; cnt += (c > 0u) ? 1u : 0u; mine = (j == x) ? c : mine; }
        if (sum == G) break;
        __builtin_amdgcn_s_sleep(1);
        if ((++sp & 255u) == 0u) { if (xb_ld(&bar[XB_TMO])) break; if (sp > XB_SPIN_CAP) { atomicAdd(&bar[XB_TMO], 1u); break; } }
    }
    nloc = mine > 0u ? mine : 1u; nx = cnt > 0u ? cnt : 1u;
}
DEVI void xcd_barrier(const XcdBarrier& b) {
    asm volatile("s_waitcnt vmcnt(0)" ::: "memory");
    __syncthreads();
    if (otid() == 0) {
        unsigned* bar = b.bar;
        __builtin_amdgcn_s_waitcnt(0);
        unsigned nloc = b.st[0], nx = b.st[1];
        if (nloc == 0u) { xcd_barrier_complete(bar, b.x, nloc, nx); b.st[0] = nloc; b.st[1] = nx; }
        const unsigned old = xb_add(&bar[XB_XSUB(b.x)], 1u);
        const unsigned gen = old / nloc;
        if (old + 1u == (gen + 1u) * nloc) {
            __builtin_amdgcn_fence(__ATOMIC_RELEASE, "agent");
            asm volatile("s_waitcnt vmcnt(0)" ::: "memory");
            const unsigned og = xb_add(&bar[XB_TOP], 1u);
            const unsigned tg = og / nx;
            if (og + 1u == (tg + 1u) * nx) xb_add(&bar[XB_TOPGEN], 1u);
            else XB_SPIN(xb_ld(&bar[XB_TOPGEN]) == tg, bar);
            __builtin_amdgcn_fence(__ATOMIC_ACQUIRE, "agent");
            xb_add(&bar[XB_XGEN(b.x)], 1u);
            asm volatile("s_waitcnt vmcnt(0)" ::: "memory");
        } else {
            XB_SPIN(xb_ld(&bar[XB_XGEN(b.x)]) == gen, bar);
            __builtin_amdgcn_fence(__ATOMIC_ACQUIRE, "agent");
            asm volatile("s_waitcnt vmcnt(0)" ::: "memory");
        }
    }
    __syncthreads();
}

template <int EPI> DEVI void run_gemm(LAS unsigned char* lds, const GemmDesc& d) {
    pg8::StaticOrder so; so.init(S, d.N, (int)gridDim.x, obid());
    if (EPI == 0) { pg8::EpiBf16 e{(bf16_t*)d.out, d.ldc, d.rs_in, d.rs_n}; pg8::gemm_phase(lds, d.A, d.Bt, d.lda, d.ldb, d.K, so, e); }
    else if (EPI == 1) { pg8::EpiSwiglu e{(bf16_t*)d.out, d.ldc, d.rs_in, d.rs_n}; pg8::gemm_phase(lds, d.A, d.Bt, d.lda, d.ldb, d.K, so, e); }
    else { pg8::EpiResid e{(float*)d.out, d.res, d.ldc, d.scale, d.hb_out, d.rs_out}; pg8::gemm_phase(lds, d.A, d.Bt, d.lda, d.ldb, d.K, so, e); }
}
enum { G_GU0 = 0, G_DN0, G_WINE, G_UQ, G_UKV, G_LORA, G_WOUTE, G_GU1, G_DN1, G_GU2, G_DN2, G_WINO, G_WOUTO, G_GU3, G_DN3 };
__global__ void __launch_bounds__(512, 2) hybrid_fwd(const Params P) {
    extern __shared__ __attribute__((aligned(16))) unsigned char smem[];
    LAS unsigned char* lds = (LAS unsigned char*)smem;
    cg::grid_group grid = cg::this_grid();
    volatile LAS unsigned* xst = (volatile LAS unsigned*)(lds + LDS_BYTES - 32);
    unsigned* xbar = (unsigned*)(P.ws + OFF_BAR);
    if (otid() == 0) { xst[0] = 0u; xst[1] = 0u; }
    if (obid() == 0) { for (int i = otid(); i < XCD_BAR_WORDS; i += NT) __hip_atomic_store(xbar + i, 0u, __ATOMIC_RELAXED, __HIP_MEMORY_SCOPE_AGENT); }
    __syncthreads();
#define SYNC() xcd_barrier(xb)
#define PH(k) if (PHMASK & (1 << (k)))
#define REP(bit) for (int rep_ = 0; rep_ < ((PROBE & (bit)) ? 2 : 1); ++rep_)
    REP(4) { PH(0) init_phase((LAS float*)lds, P); }
    REP(4) { PH(1) xprep_rows(P.in[0], (bf16_t*)(P.ws + OFF_XN), (float*)(P.ws + OFF_RS)); }
    grid.sync();
    const XcdBarrier xb = xcd_barrier_post(xbar, xst);
    REP(16) { PH(1) cvt_dn((LAS float*)lds, P, 0); }
    REP(1) { PH(2) run_gemm<1>(lds, P.gd[G_GU0]); SYNC(); }
    REP(16) { PH(1) cvt_gu((LAS float*)lds, P, 1); }
    REP(1) { PH(2) run_gemm<2>(lds, P.gd[G_DN0]); SYNC(); }
    REP(1) { PH(2) run_gemm<0>(lds, P.gd[G_WINE]); SYNC(); }
    REP(4) { PH(3) eprep1(P); SYNC(); }
    REP(1) { PH(2) { run_gemm<0>(lds, P.gd[G_UQ]); run_gemm<0>(lds, P.gd[G_UKV]); run_gemm<0>(lds, P.gd[G_LORA]); } SYNC(); }
    PH(4) eprep2(P); SYNC();
    REP(8) { PH(5) rwkv_A(lds, P); SYNC(); }
    REP(2) { PH(5) emix(lds, P); SYNC(); if (PROBE & 2) { if (obid() == 0 && otid() == 0) *(unsigned*)(P.ws + OFF_CNT) = 0u; SYNC(); } }
    REP(8) { PH(5) rwkv_C(lds, P); SYNC(); }
    REP(4) { PH(6) epost(P); SYNC(); }
    PH(2) run_gemm<2>(lds, P.gd[G_WOUTE]); SYNC();
    REP(16) { PH(1) cvt_dn((LAS float*)lds, P, 1); }
    REP(1) { PH(2) run_gemm<1>(lds, P.gd[G_GU1]); SYNC(); }
    REP(16) { PH(1) cvt_gu((LAS float*)lds, P, 2); }
    PH(2) run_gemm<2>(lds, P.gd[G_DN1]); SYNC();
    REP(16) { PH(1) cvt_dn((LAS float*)lds, P, 2); }
    REP(1) { PH(2) run_gemm<1>(lds, P.gd[G_GU2]); SYNC(); }
    REP(16) { PH(1) cvt_gu((LAS float*)lds, P, 3); }
    PH(2) run_gemm<2>(lds, P.gd[G_DN2]); SYNC();
    REP(1) { PH(2) run_gemm<0>(lds, P.gd[G_WINO]); SYNC(); }
    PH(7) oprep(P); SYNC();
    PH(8) { for (int it = obid(); it < 1024; it += gridDim.x) gla_local(lds, P, it); } SYNC();
    PH(8) oattn(lds, P); SYNC();
    REP(4) { PH(10) { for (int it = obid(); it < 1024; it += gridDim.x) gla_out(lds, P, it); omerge(P); } SYNC(); }
    PH(2) run_gemm<2>(lds, P.gd[G_WOUTO]); SYNC();
    REP(16) { PH(1) cvt_dn((LAS float*)lds, P, 3); }
    REP(1) { PH(2) run_gemm<1>(lds, P.gd[G_GU3]); SYNC(); }
    PH(2) run_gemm<2>(lds, P.gd[G_DN3]);
}

extern "C" void kernel_launch(void* const* d_in, const int* in_sizes, int n_in, void* d_out, int out_size, void* d_ws, size_t ws_size, hipStream_t stream) {
    static int grid_blocks = 0;
    if (!grid_blocks) {
        int dev = 0, cus = 0, per_cu = 0;
        hipGetDevice(&dev);
        hipDeviceGetAttribute(&cus, hipDeviceAttributeMultiprocessorCount, dev);
        hipFuncSetAttribute((const void*)hybrid_fwd, hipFuncAttributeMaxDynamicSharedMemorySize, LDS_BYTES);
        hipOccupancyMaxActiveBlocksPerMultiprocessor(&per_cu, hybrid_fwd, NT, LDS_BYTES);
        if (per_cu < 1) per_cu = 1;
        grid_blocks = cus * 1;
        if (ws_size < WS_NEED) fprintf(stderr, "workspace too small: %zu < %zu\n", ws_size, (size_t)WS_NEED);
    }
    Params P; memset(&P, 0, sizeof(P));
    for (int i = 0; i < 33; ++i) P.in[i] = (const float*)d_in[i];
    P.out = (float*)d_out; P.ws = (unsigned char*)d_ws;
    unsigned char* ws = (unsigned char*)d_ws;
    auto B = [&](size_t off) { return (const bf16_t*)(ws + off); };
    int ng = 0;
    float* rsA = (float*)(ws + OFF_RS); float* rsB = rsA + (size_t)S * 32;
    auto gemm = [&](const bf16_t* A, int lda, const bf16_t* Bt, int ldb, int N, int K, int epi, void* out, int ldc, const float* res, float scale,
                    const float* rs_in, int rs_n, float* rs_out, bf16_t* hb_out) {
        GemmDesc& g = P.gd[ng]; g.A = A; g.Bt = Bt; g.out = out; g.res = res; g.rs_in = rs_in; g.rs_out = rs_out; g.hb_out = hb_out;
        g.lda = lda; g.ldb = ldb; g.ldc = ldc; g.N = N; g.K = K; g.epi = epi; g.scale = scale; g.rs_n = rs_n; return ng++; };
    bf16_t* XN = (bf16_t*)(ws + OFF_XN); bf16_t* HB = (bf16_t*)(ws + OFF_HB);
    const float* fout = (const float*)d_out;
    gemm(XN, DM, B(OFF_GUT), DM, 2 * DFF, DM, 1, ws + OFF_HID, DFF, nullptr, 0.f, rsA, 1, nullptr, nullptr);
    gemm(B(OFF_HID), DFF, B(OFF_DT), DFF, DM, DFF, 2, d_out, DM, (const float*)d_in[0], 0.5f, nullptr, 0, rsB, XN);
    gemm(XN, DM, B(OFF_WINE), DM, EVEN_LD, DM, 0, ws + E_P, EVEN_LD, nullptr, 0.f, rsB, 32, nullptr, nullptr);
    gemm(B(E_CQN), 512, B(OFF_WUQ), 512, 1536, 512, 0, ws + E_Q, 1536, nullptr, 0.f, nullptr, 0, nullptr, nullptr);
    gemm(B(E_CKVN), 256, B(OFF_WUKV), 256, 2048, 256, 0, ws + E_KV, 2048, nullptr, 0.f, nullptr, 0, nullptr, nullptr);
    gemm(B(E_LIN), 384, B(OFF_LORA), 384, 3072, 384, 0, ws + E_LOUT, 3072, nullptr, 0.f, nullptr, 0, nullptr, nullptr);
    gemm(XN, DM, B(OFF_WOUTE), DM, DM, DM, 2, d_out, DM, fout, 1.0f, nullptr, 0, rsB, HB);
    gemm(HB, DM, B(OFF_GUT), DM, 2 * DFF, DM, 1, ws + OFF_HID, DFF, nullptr, 0.f, rsB, 32, nullptr, nullptr);
    gemm(B(OFF_HID), DFF, B(OFF_DT), DFF, DM, DFF, 2, d_out, DM, fout, 0.5f, nullptr, 0, rsB, XN);
    gemm(XN, DM, B(OFF_GUT), DM, 2 * DFF, DM, 1, ws + OFF_HID, DFF, nullptr, 0.f, rsB, 32, nullptr, nullptr);
    gemm(B(OFF_HID), DFF, B(OFF_DT), DFF, DM, DFF, 2, d_out, DM, fout, 0.5f, nullptr, 0, rsB, XN);
    gemm(XN, DM, B(OFF_WINO), DM, ODD_LD, DM, 0, ws + O_P, ODD_LD, nullptr, 0.f, rsB, 32, nullptr, nullptr);
    gemm(XN, DM, B(OFF_WOUTO), DM, DM, DM, 2, d_out, DM, fout, 1.0f, nullptr, 0, rsB, HB);
    gemm(HB, DM, B(OFF_GUT), DM, 2 * DFF, DM, 1, ws + OFF_HID, DFF, nullptr, 0.f, rsB, 32, nullptr, nullptr);
    gemm(B(OFF_HID), DFF, B(OFF_DT), DFF, DM, DFF, 2, d_out, DM, fout, 0.5f, nullptr, 0, nullptr, nullptr);
    P.nsteps = 0;
    void* args[] = {&P};
    hipError_t e = hipLaunchCooperativeKernel((const void*)hybrid_fwd, dim3(grid_blocks), dim3(NT), args, LDS_BYTES, stream);
    if (e != hipSuccess) fprintf(stderr, "cooperative launch failed: %s (grid %d)\n", hipGetErrorString(e), grid_blocks);
}
```

```cpp
#include <hip/hip_runtime.h>
#include <hip/hip_cooperative_groups.h>
#include <cstdio>
#include <cstring>
namespace cg = cooperative_groups;
#ifndef PROBE
#define PROBE 0
#endif
#ifndef PHMASK
#define PHMASK 0xFFFF
#endif

#define LAS __attribute__((address_space(3)))
#define DEVI __device__ __forceinline__
typedef unsigned short bf16_t;
typedef short bf16x8 __attribute__((ext_vector_type(8)));
typedef short s16x4 __attribute__((ext_vector_type(4)));
typedef float f32x4 __attribute__((ext_vector_type(4)));
typedef float f32x2 __attribute__((ext_vector_type(2)));
typedef float f32x16 __attribute__((ext_vector_type(16)));
typedef unsigned u32x4 __attribute__((ext_vector_type(4)));
typedef unsigned u32x2 __attribute__((ext_vector_type(2)));

constexpr int S = 16384, DM = 2048, DFF = 5632;
constexpr int EVEN_LD = 4352, ODD_LD = 6400;
constexpr int NT = 512;
constexpr int LDS_BYTES = 147456;

constexpr size_t SZ = (size_t)S;
constexpr size_t OFF_CNT = 0;
constexpr size_t OFF_RS = 1024;
constexpr size_t OFF_BAR = OFF_RS + 64 * SZ * 4;
constexpr size_t OFF_WINE = OFF_BAR + 16384;
constexpr size_t OFF_WUQ = OFF_WINE + (size_t)EVEN_LD * 2048 * 2;
constexpr size_t OFF_WUKV = OFF_WUQ + (size_t)1536 * 512 * 2;
constexpr size_t OFF_LORA = OFF_WUKV + (size_t)2048 * 256 * 2;
constexpr size_t OFF_WOUTE = OFF_LORA + (size_t)3072 * 384 * 2;
constexpr size_t OFF_WINO = OFF_WOUTE + (size_t)2048 * 2048 * 2;
constexpr size_t OFF_WOUTO = OFF_WINO + (size_t)ODD_LD * 2048 * 2;
constexpr size_t OFF_ROPE64 = OFF_WOUTO + (size_t)2048 * 2048 * 2;
constexpr size_t OFF_ROPE128 = OFF_ROPE64 + SZ * 64 * 4;
constexpr size_t OFF_GUT = OFF_ROPE128 + SZ * 128 * 4;
constexpr size_t OFF_DT = OFF_GUT + (size_t)11264 * 2048 * 2;
constexpr size_t OFF_XN = OFF_DT + (size_t)2048 * 5632 * 2;
constexpr size_t OFF_BIG = OFF_XN + SZ * 2048 * 2;
constexpr size_t OFF_HB = OFF_BIG;
constexpr size_t OFF_HID = OFF_BIG + SZ * 2048 * 2;
constexpr size_t E_P = OFF_BIG;
constexpr size_t E_R = E_P + SZ * EVEN_LD * 2;
constexpr size_t E_KB = E_R + SZ * 1024 * 2;
constexpr size_t E_V = E_KB + SZ * 1024 * 2;
constexpr size_t E_CQN = E_V + SZ * 1024 * 2;
constexpr size_t E_CKVN = E_CQN + SZ * 512 * 2;
constexpr size_t E_LIN = E_CKVN + SZ * 256 * 2;
constexpr size_t E_KR = E_LIN + SZ * 384 * 2;
constexpr size_t E_Q = E_KR + SZ * 64 * 2;
constexpr size_t E_KV = E_Q + SZ * 1536 * 2;
constexpr size_t E_K = E_KV + SZ * 2048 * 2;
constexpr size_t E_LOUT = E_K + SZ * 1536 * 2;
constexpr size_t E_SIN = E_LOUT + SZ * 3072 * 2;
constexpr size_t E_END = E_SIN + (size_t)16 * 64 * 4096 * 4;
constexpr size_t E_PU = E_KB;
constexpr size_t E_DECAY = E_P;
constexpr size_t E_KH = E_P + SZ * 1024 * 4;
constexpr size_t E_NA = E_KH + SZ * 1024 * 2;
constexpr size_t E_BB = E_CQN;
constexpr size_t E_Y = E_KB;
constexpr size_t O_P = OFF_BIG;
constexpr size_t O_LG = O_P + SZ * ODD_LD * 2;
constexpr size_t O_UST = O_LG + SZ * 512 * 4;
constexpr size_t O_DVEC = O_UST + (size_t)256 * 4 * 128 * 256 * 4;
constexpr size_t O_OPAT = O_DVEC + (size_t)256 * 4 * 128 * 4;
constexpr size_t O_LSE = O_OPAT + 3 * SZ * 1024 * 2;
constexpr size_t O_END = O_LSE + 3 * SZ * 8 * 4;
constexpr size_t FFN_END = OFF_HID + SZ * 5632 * 2;
constexpr size_t WS_NEED = (E_END > O_END ? (E_END > FFN_END ? E_END : FFN_END) : (O_END > FFN_END ? O_END : FFN_END));

DEVI int otid() { int t = __builtin_amdgcn_workitem_id_x(); asm volatile("" : "+v"(t)); return t; }
DEVI int obid() { int b = __builtin_amdgcn_workgroup_id_x(); asm volatile("" : "+s"(b)); return b; }
DEVI unsigned pk_bf16(float lo, float hi) { unsigned r; asm("v_cvt_pk_bf16_f32 %0, %1, %2" : "=v"(r) : "v"(lo), "v"(hi)); return r; }
DEVI float bf_lo(unsigned u) { return __uint_as_float(u << 16); }
DEVI float bf_hi(unsigned u) { return __uint_as_float(u & 0xffff0000u); }
DEVI float bf2f(bf16_t b) { return __uint_as_float(((unsigned)b) << 16); }
DEVI bf16_t f2bf(float f) { return (bf16_t)(pk_bf16(f, 0.f) & 0xffffu); }
DEVI unsigned xb_xcc_id() { return (unsigned)__builtin_amdgcn_s_getreg((3 << 11) | 20) & 0xFu; }
DEVI float wave_sum(float v) {
#pragma unroll
    for (int o = 32; o > 0; o >>= 1) v += __shfl_xor(v, o);
    return v;
}
DEVI float sigmoidf_(float x) { return __builtin_amdgcn_rcpf(1.0f + __expf(-x)); }
DEVI float siluf_(float x) { return x * __builtin_amdgcn_rcpf(1.0f + __expf(-x)); }
DEVI void unpack8(u32x4 u, float* f) {
    f[0] = bf_lo(u.x); f[1] = bf_hi(u.x); f[2] = bf_lo(u.y); f[3] = bf_hi(u.y);
    f[4] = bf_lo(u.z); f[5] = bf_hi(u.z); f[6] = bf_lo(u.w); f[7] = bf_hi(u.w);
}
DEVI u32x4 pack8(const float* f) { u32x4 u; u.x = pk_bf16(f[0], f[1]); u.y = pk_bf16(f[2], f[3]); u.z = pk_bf16(f[4], f[5]); u.w = pk_bf16(f[6], f[7]); return u; }

struct GemmDesc { const bf16_t* A; const bf16_t* Bt; void* out; const float* res; const float* rs_in; float* rs_out; bf16_t* hb_out; int lda, ldb, ldc, N, K, epi; float scale; int rs_n; };
struct Step { int kind, a0, a1, a2, sync, p0, p1, p2; };
enum { K_INIT = 0, K_NORM, K_GEMM, K_EPREP1, K_EPREP2, K_EMIX, K_EPOST, K_OPREP, K_OATTN, K_GSCAN, K_OFINAL };
struct Params {
    const float* in[33];
    float* out;
    unsigned char* ws;
    GemmDesc gd[16];
    Step st[32];
    int nsteps, pad;
};

namespace pg8 {
constexpr int BM = 256, BK = 64, HALF = 128, HTB = HALF * BK * 2, STAGE_BYTES = 8 * HTB, NXCD = 8, WGM = 8;
DEVI int lds_byte(int r, int c) { const int st = (r >> 4) * 2 + (c >> 5), rr = r & 15, cc = c & 31, ob = rr * 64 + cc * 2; return st * 1024 + (ob ^ (((ob >> 9) & 1) << 5)); }
DEVI void stage_rc(int b, int& R, int& C) { const int st = b / 1024, sb = b % 1024, swz = sb ^ (((sb >> 9) & 1) << 5); R = (st >> 1) * 16 + swz / 64; C = (st & 1) * 32 + (swz % 64) / 2; }
DEVI int perm32(int rho) { const int n = rho >> 4, i = rho & 15; return 8 * (i >> 2) + 4 * n + (i & 3); }
struct Unit { int pm, pn; };
struct StaticOrder {
    int nM, nN, nwg, G, c;
    DEVI void init(int M, int N, int G_, int c_) { nM = M / BM; nN = N / BM; nwg = nM * nN; G = G_; c = c_; }
    DEVI bool next(int i, Unit& u) const {
        const long L = (long)i * G + c; if (L >= nwg) return false;
        int wgid = (int)L; { const int q = nwg / NXCD, r = nwg % NXCD, xcd = wgid % NXCD, off = wgid / NXCD; wgid = (xcd < r ? xcd * (q + 1) : r * (q + 1) + (xcd - r) * q) + off; }
        const int nig = WGM * nN, gid = wgid / nig, fm = gid * WGM, gsz = (nM - fm) < WGM ? (nM - fm) : WGM;
        u.pm = fm + ((wgid % nig) % gsz); u.pn = (wgid % nig) / gsz; return true;
    }
};
DEVI float row_rstd(const LAS float* rsl, int r) { return rsqrtf((rsl[r] + rsl[256 + r]) * (1.0f / DM) + 1e-6f); }
struct EpiBf16 {
    static constexpr bool PERM = true, HAS_RS = true;
    bf16_t* O_; int ldc_; const float* rs_; int rsn_;
    DEVI void operator()(const f32x4 (&acc)[2][2][4][2], const Unit& u, int wr, int wc, int fr, int fq, const LAS float* rsl) const {
        bf16_t* const O = O_; const int ldc = ldc_; const float* const rs = rs_; const int rsn = rsn_;
        const int row0 = u.pm * BM + wr * 64 + fr, col0 = u.pn * BM + wc * 32 + 8 * fq;
#pragma unroll
        for (int ai = 0; ai < 2; ++ai)
#pragma unroll
            for (int m = 0; m < 4; ++m) { bf16_t* rowp = O + (size_t)(row0 + ai * HALF + m * 16) * ldc + col0;
                const float sc = rs ? row_rstd(rsl, wr * 64 + fr + ai * HALF + m * 16) : 1.0f;
#pragma unroll
                for (int bj = 0; bj < 2; ++bj) { const f32x4 v0 = acc[ai][bj][m][0] * sc, v1 = acc[ai][bj][m][1] * sc;
                    u32x4 w; w.x = pk_bf16(v0[0], v0[1]); w.y = pk_bf16(v0[2], v0[3]); w.z = pk_bf16(v1[0], v1[1]); w.w = pk_bf16(v1[2], v1[3]);
                    *(u32x4*)(rowp + bj * HALF) = w; } }
    }
};
struct EpiSwiglu {
    static constexpr bool PERM = true, HAS_RS = true;
    bf16_t* O_; int ldc_; const float* rs_; int rsn_;
    DEVI void operator()(const f32x4 (&acc)[2][2][4][2], const Unit& u, int wr, int wc, int fr, int fq, const LAS float* rsl) const {
        bf16_t* const O = O_; const int ldc = ldc_; const float* const rs = rs_; const int rsn = rsn_;
        const int row0 = u.pm * BM + wr * 64 + fr, col0 = u.pn * HALF + wc * 32 + 8 * fq;
#pragma unroll
        for (int ai = 0; ai < 2; ++ai)
#pragma unroll
            for (int m = 0; m < 4; ++m) { bf16_t* rowp = O + (size_t)(row0 + ai * HALF + m * 16) * ldc + col0;
                const float sc = row_rstd(rsl, wr * 64 + fr + ai * HALF + m * 16);
                const float k1 = -1.4426950408889634f * sc, k2 = sc * sc;
                float h[8], tt[8];
                const f32x4 guk0 = (acc[ai][0][m][0] * acc[ai][1][m][0]) * k2, guk1 = (acc[ai][0][m][1] * acc[ai][1][m][1]) * k2;
                const f32x4 ta = acc[ai][0][m][0] * k1, tb = acc[ai][0][m][1] * k1;
#pragma unroll
                for (int j = 0; j < 4; ++j) { tt[j] = __builtin_amdgcn_exp2f(ta[j]); tt[4 + j] = __builtin_amdgcn_exp2f(tb[j]); }
                __builtin_amdgcn_sched_barrier(0);
#pragma unroll
                for (int j = 0; j < 8; ++j) tt[j] = __builtin_amdgcn_rcpf(1.0f + tt[j]);
                __builtin_amdgcn_sched_barrier(0);
#pragma unroll
                for (int j = 0; j < 4; ++j) { h[j] = guk0[j] * tt[j]; h[4 + j] = guk1[j] * tt[4 + j]; }
                *(u32x4*)rowp = pack8(h); }
    }
};
struct EpiResid {
    static constexpr bool PERM = false, HAS_RS = false;
    float* C_; const float* R_; int ldc_; float scale_; bf16_t* HB_; float* RS_;
    DEVI void operator()(const f32x4 (&acc)[2][2][4][2], const Unit& u, int wr, int wc, int fr, int fq, const LAS float*) const {
        float* const C = C_; const float* const R = R_; const int ldc = ldc_; bf16_t* const HB = HB_; float* const RS = RS_;
        float scale = scale_; asm volatile("" : "+v"(scale));
        const int row0 = u.pm * BM + wr * 64 + fr, col0 = u.pn * BM + wc * 32 + 4 * fq;
        f32x4 cur[2][2], nxt[2][2];
        { const size_t ro = (size_t)row0 * ldc + col0;
#pragma unroll
          for (int bj = 0; bj < 2; ++bj)
#pragma unroll
              for (int n = 0; n < 2; ++n) cur[bj][n] = *(const f32x4*)(R + ro + bj * HALF + n * 16); }
#pragma unroll
        for (int idx = 0; idx < 8; ++idx) {
            const int ai = idx >> 2, m = idx & 3;
            const size_t ro = (size_t)(row0 + ai * HALF + m * 16) * ldc + col0;
            if (idx + 1 < 8) { const int ai2 = (idx + 1) >> 2, m2 = (idx + 1) & 3; const size_t ro2 = (size_t)(row0 + ai2 * HALF + m2 * 16) * ldc + col0;
#pragma unroll
                for (int bj = 0; bj < 2; ++bj)
#pragma unroll
                    for (int n = 0; n < 2; ++n) nxt[bj][n] = *(const f32x4*)(R + ro2 + bj * HALF + n * 16); }
            float ss = 0.f;
#pragma unroll
            for (int bj = 0; bj < 2; ++bj)
#pragma unroll
                for (int n = 0; n < 2; ++n) {
                    const f32x4 hn = cur[bj][n] + acc[ai][bj][m][n] * scale;
                    *(f32x4*)(C + ro + bj * HALF + n * 16) = hn;
                    if (HB) { u32x2 w; w.x = pk_bf16(hn[0], hn[1]); w.y = pk_bf16(hn[2], hn[3]); *(u32x2*)(HB + ro + bj * HALF + n * 16) = w;
                        ss += hn[0] * hn[0] + hn[1] * hn[1] + hn[2] * hn[2] + hn[3] * hn[3]; } }
            if (HB) { ss += __shfl_xor(ss, 16); ss += __shfl_xor(ss, 32); if (fq == 0) RS[(size_t)(row0 + ai * HALF + m * 16) * 32 + u.pn * 4 + wc] = ss; }
#pragma unroll
            for (int bj = 0; bj < 2; ++bj)
#pragma unroll
                for (int n = 0; n < 2; ++n) cur[bj][n] = nxt[bj][n];
        }
    }
};

template <class Epi>
DEVI void gemm_phase(LAS unsigned char* lds, const bf16_t* gA, const bf16_t* gBt, const int lda, const int ldb, const int K, const StaticOrder S_, const Epi E) {
    const int tid = otid(), wid = __builtin_amdgcn_readfirstlane(tid >> 6), lane = tid & 63, wr = wid >> 2, wc = wid & 3, fr = lane & 15, fq = lane >> 4;
    const int nt = K / BK;
    unsigned voffA[2], voffB[2];
#pragma unroll
    for (int i = 0; i < 2; ++i) { int R, C; stage_rc(tid * 16 + i * 8192, R, C); const int Rb = Epi::PERM ? ((R & ~31) + perm32(R & 31)) : R;
        voffA[i] = (unsigned)(R * lda + C) * 2u; voffB[i] = (unsigned)(Rb * ldb + C) * 2u; }
    const size_t kstep = (size_t)(BK * 2);
    const size_t hstepA = (size_t)HALF * lda * 2, hstepB = (size_t)HALF * ldb * 2;
    const size_t tstepA = 2 * hstepA, tstepB = 2 * hstepB;
    const unsigned ldsw = (unsigned)wid * 1024u;
    const int aoff = lds_byte(wr * 64 + fr, fq * 8), boff = lds_byte(wc * 32 + fr, fq * 8);
#define PG8_SA(b, h) (((b) * 2 + (h)) * HTB)
#define PG8_SB(b, h) ((4 + (b) * 2 + (h)) * HTB)
#define PG8_STAGE(bufoff, gbase, voff) do { _Pragma("unroll") for (int _i = 0; _i < 2; ++_i) \
        __builtin_amdgcn_global_load_lds((const unsigned*)((const char*)(gbase) + (voff)[_i]), (LAS unsigned*)(lds + (bufoff) + ldsw + _i * 8192), 16, 0, 0); } while (0)
#define PG8_LDA(dst, b, h) do { _Pragma("unroll") for (int m = 0; m < 4; ++m) _Pragma("unroll") for (int k = 0; k < 2; ++k) dst[m][k] = *(const LAS bf16x8*)(lds + PG8_SA(b, h) + aoff + m * 2048 + k * 1024); } while (0)
#define PG8_LDB(dst, b, h) do { _Pragma("unroll") for (int n = 0; n < 2; ++n) _Pragma("unroll") for (int k = 0; k < 2; ++k) dst[n][k] = *(const LAS bf16x8*)(lds + PG8_SB(b, h) + boff + n * 2048 + k * 1024); } while (0)
#define PG8_MMA(ai, bj, At, Bt) do { __builtin_amdgcn_s_setprio(1); _Pragma("unroll") for (int m = 0; m < 4; ++m) _Pragma("unroll") for (int n = 0; n < 2; ++n) _Pragma("unroll") for (int k = 0; k < 2; ++k) \
        acc[ai][bj][m][n] = __builtin_amdgcn_mfma_f32_16x16x32_bf16(Bt[n][k], At[m][k], acc[ai][bj][m][n], 0, 0, 0); __builtin_amdgcn_s_setprio(0); } while (0)
#define PG8_WAIT_V(n) asm volatile("s_waitcnt vmcnt(" #n ")" ::: "memory")
#define PG8_WAIT_L(n) asm volatile("s_waitcnt lgkmcnt(" #n ")" ::: "memory")
#define PG8_BAR __builtin_amdgcn_s_barrier()
#define PG8_SCHED __builtin_amdgcn_sched_barrier(0)
    Unit cur, nxt; int ui = 0;
    if (!S_.next(0, cur)) return;
    auto rs_prefetch = [&](const Unit& u, int par) {
        if constexpr (Epi::HAS_RS) { if (E.rs_) {
            const int r = tid & 255, hf = tid >> 8; float s = 0.f;
            const float* base = E.rs_ + (size_t)(u.pm * BM + r) * 32 + hf * 16;
            if (E.rsn_ == 32) {
                const f32x4 a = *(const f32x4*)base, b = *(const f32x4*)(base + 4), c = *(const f32x4*)(base + 8), d = *(const f32x4*)(base + 12);
                s = ((a[0] + a[1]) + (a[2] + a[3])) + ((b[0] + b[1]) + (b[2] + b[3])) + ((c[0] + c[1]) + (c[2] + c[3])) + ((d[0] + d[1]) + (d[2] + d[3]));
            } else if (hf == 0) s = base[0];
            *(LAS float*)(lds + STAGE_BYTES + par * 2048 + hf * 1024 + r * 4) = s; } }
    };
    f32x4 acc[2][2][4][2];
#pragma unroll
    for (int a = 0; a < 2; ++a)
#pragma unroll
        for (int b = 0; b < 2; ++b)
#pragma unroll
            for (int m = 0; m < 4; ++m)
#pragma unroll
                for (int n = 0; n < 2; ++n) acc[a][b][m][n] = (f32x4){0.f, 0.f, 0.f, 0.f};
    bf16x8 At[4][2], B0[2][2], B1[2][2];
    const char* cA = (const char*)gA + (size_t)cur.pm * tstepA; const char* cB = (const char*)gBt + (size_t)cur.pn * tstepB;
    PG8_STAGE(PG8_SB(0, 0), cB, voffB); PG8_STAGE(PG8_SA(0, 0), cA, voffA); PG8_STAGE(PG8_SB(0, 1), cB + hstepB, voffB); PG8_STAGE(PG8_SA(0, 1), cA + hstepA, voffA);
    if (wr == 1) PG8_BAR;
    PG8_WAIT_V(4); PG8_BAR;
    PG8_STAGE(PG8_SB(1, 0), cB + kstep, voffB); PG8_STAGE(PG8_SA(1, 0), cA + kstep, voffA); PG8_STAGE(PG8_SB(1, 1), cB + hstepB + kstep, voffB);
    PG8_WAIT_V(6); PG8_BAR;
    rs_prefetch(cur, 0);
    for (;;) {
        const bool has_next = S_.next(ui + 1, nxt);
        const char* nA = has_next ? (const char*)gA + (size_t)nxt.pm * tstepA : cA; const char* nB = has_next ? (const char*)gBt + (size_t)nxt.pn * tstepB : cB;
        for (int t = 0; t < nt; t += 2) {
            const bool last = (t == nt - 2);
            const char* a1 = cA + (size_t)(t + 1) * kstep;
            const char* a2 = last ? nA : cA + (size_t)(t + 2) * kstep; const char* b2 = last ? nB : cB + (size_t)(t + 2) * kstep;
            const char* a3 = a2 + kstep; const char* b3 = b2 + kstep;
            PG8_LDB(B0, 0, 0); PG8_SCHED; PG8_LDA(At, 0, 0); PG8_STAGE(PG8_SA(1, 1), a1 + hstepA, voffA);
            PG8_WAIT_L(8); PG8_BAR; PG8_WAIT_L(0); PG8_MMA(0, 0, At, B0); PG8_BAR; PG8_SCHED;
            PG8_LDB(B1, 0, 1); PG8_STAGE(PG8_SB(0, 0), b2, voffB);
            PG8_BAR; PG8_WAIT_L(0); PG8_MMA(0, 1, At, B1); PG8_BAR;
            PG8_LDA(At, 0, 1); PG8_STAGE(PG8_SA(0, 0), a2, voffA);
            PG8_BAR; PG8_WAIT_L(0); PG8_MMA(1, 0, At, B0); PG8_BAR; PG8_SCHED;
            PG8_STAGE(PG8_SB(0, 1), b2 + hstepB, voffB);
            PG8_WAIT_V(6); PG8_BAR; PG8_MMA(1, 1, At, B1); PG8_BAR;
            PG8_LDB(B0, 1, 0); PG8_SCHED; PG8_LDA(At, 1, 0); PG8_STAGE(PG8_SA(0, 1), a2 + hstepA, voffA);
            PG8_WAIT_L(8); PG8_BAR; PG8_WAIT_L(0); PG8_MMA(0, 0, At, B0); PG8_BAR; PG8_SCHED;
            PG8_LDB(B1, 1, 1); PG8_STAGE(PG8_SB(1, 0), b3, voffB);
            PG8_BAR; PG8_WAIT_L(0); PG8_MMA(0, 1, At, B1); PG8_BAR;
            PG8_LDA(At, 1, 1); PG8_STAGE(PG8_SA(1, 0), a3, voffA);
            PG8_BAR; PG8_WAIT_L(0); PG8_MMA(1, 0, At, B0); PG8_BAR; PG8_SCHED;
            PG8_STAGE(PG8_SB(1, 1), b3 + hstepB, voffB);
            PG8_WAIT_V(6); PG8_BAR; PG8_MMA(1, 1, At, B1); PG8_BAR;
        }
        E(acc, cur, wr, wc, fr, fq, (const LAS float*)(lds + STAGE_BYTES + (ui & 1) * 2048));
        if (!has_next) break;
#pragma unroll
        for (int a = 0; a < 2; ++a)
#pragma unroll
            for (int b = 0; b < 2; ++b)
#pragma unroll
                for (int m = 0; m < 4; ++m)
#pragma unroll
                    for (int n = 0; n < 2; ++n) acc[a][b][m][n] = (f32x4){0.f, 0.f, 0.f, 0.f};
        cur = nxt; cA = nA; cB = nB; ++ui;
        rs_prefetch(cur, ui & 1);
    }
    PG8_WAIT_V(0);
    if (wr == 0) PG8_BAR;
    PG8_BAR;
#undef PG8_SA
#undef PG8_SB
#undef PG8_STAGE
#undef PG8_LDA
#undef PG8_LDB
#undef PG8_MMA
#undef PG8_WAIT_V
#undef PG8_WAIT_L
#undef PG8_BAR
#undef PG8_SCHED
}
}

DEVI void cvt_job(LAS float* tile, const float* src, int srcK, int srcN, bf16_t* dst, int dstLd, int dstRows, int dstCol0, int mode, const float* gk = nullptr) {
    const int tid = otid(), ntc = dstLd >> 7, nvr = mode ? (dstRows >> 7) : (dstRows >> 6), ntot = nvr * ntc;
    const int tx = tid & 63, ty = tid >> 6;
    float regsA[16], regsB[16];
    auto coords = [&](int t, int& rho0, int& kap0, int& n0) {
        const int tc = t / nvr, v = t - tc * nvr; kap0 = tc << 7;
        if (mode) { const int tr = ((v >> 1) << 2) + (mode == 2 ? 2 : 0) + (v & 1); rho0 = tr << 6; n0 = ((rho0 >> 8) << 7) + (rho0 & 127); }
        else { rho0 = v << 6; n0 = rho0; }
    };
    auto gl = [&](int t, float (&regs)[16]) {
        int rho0, kap0, n0; coords(t, rho0, kap0, n0);
        const int n = n0 + tx, nc = n < srcN ? n : srcN - 1;
        const bool nok = n < srcN;
        float raw[16], gs[16];
#pragma unroll
        for (int i = 0; i < 16; ++i) { const int k = kap0 + ty + 8 * i - dstCol0; const int kc = k < 0 ? 0 : (k < srcK ? k : srcK - 1);
            raw[i] = __builtin_nontemporal_load(src + (size_t)kc * srcN + nc); }
        if (gk) {
#pragma unroll
            for (int i = 0; i < 16; ++i) { const int k = kap0 + ty + 8 * i - dstCol0; const int kc = k < 0 ? 0 : (k < srcK ? k : srcK - 1); gs[i] = gk[kc]; }
        } else {
#pragma unroll
            for (int i = 0; i < 16; ++i) gs[i] = 1.0f;
        }
#pragma unroll
        for (int i = 0; i < 16; ++i) { const int k = kap0 + ty + 8 * i - dstCol0; regs[i] = (nok && k >= 0 && k < srcK) ? raw[i] * gs[i] : 0.f; }
    };
    auto emit = [&](int t, float (&regs)[16]) {
#pragma unroll
        for (int i = 0; i < 16; ++i) tile[(ty + 8 * i) * 65 + tx] = regs[i];
        __syncthreads();
        int rho0, kap0, n0; coords(t, rho0, kap0, n0);
        const int tn = t + 2 * gridDim.x;
        if (tn < ntot) gl(tn, regs);
#pragma unroll
        for (int i = 0; i < 8; ++i) { const int row = ty + 8 * i;
            const float lo = tile[(2 * tx) * 65 + row], hi = tile[(2 * tx + 1) * 65 + row];
            *(unsigned*)(dst + (size_t)(rho0 + row) * dstLd + kap0 + 2 * tx) = pk_bf16(lo, hi); }
        __syncthreads();
    };
    const int G = gridDim.x;
    int t = obid();
    if (t < ntot) gl(t, regsA);
    if (t + G < ntot) gl(t + G, regsB);
    while (t < ntot) {
        emit(t, regsA);
        if (t + G < ntot) emit(t + G, regsB);
        t += 2 * G;
    }
}
DEVI void cvt_gu(LAS float* tile, const Params& P, int idx) {
    bf16_t* gut = (bf16_t*)(P.ws + OFF_GUT);
    const size_t wo = (size_t)idx * DM * DFF; const float* g = P.in[2] + (size_t)idx * DM;
    cvt_job(tile, P.in[3] + wo, DM, DFF, gut, DM, 2 * DFF, 0, 1, g);
    cvt_job(tile, P.in[4] + wo, DM, DFF, gut, DM, 2 * DFF, 0, 2, g);
}
DEVI void cvt_dn(LAS float* tile, const Params& P, int idx) {
    cvt_job(tile, P.in[5] + (size_t)idx * DM * DFF, DFF, DM, (bf16_t*)(P.ws + OFF_DT), DFF, DM, 0, 0);
}

DEVI void xprep_rows(const float* in, bf16_t* out, float* rs) {
    const int wave = otid() >> 6, lane = otid() & 63;
    for (int row = obid() * 8 + wave; row < S; row += gridDim.x * 8) {
        const f32x4* p = (const f32x4*)(in + (size_t)row * DM);
        f32x4 v[8]; float ss = 0.f;
#pragma unroll
        for (int i = 0; i < 8; ++i) { v[i] = p[lane + 64 * i]; ss += v[i][0] * v[i][0] + v[i][1] * v[i][1] + v[i][2] * v[i][2] + v[i][3] * v[i][3]; }
        ss = wave_sum(ss);
        if (lane == 0) rs[(size_t)row * 32] = ss;
#pragma unroll
        for (int i = 0; i < 8; ++i) { u32x2 o; o.x = pk_bf16(v[i][0], v[i][1]); o.y = pk_bf16(v[i][2], v[i][3]);
            *(u32x2*)(out + (size_t)row * DM + (lane + 64 * i) * 4) = o; }
    }
}

DEVI void init_phase(LAS float* tile, const Params& P) {
    unsigned char* ws = P.ws;
    if (obid() == 0 && otid() < 64) ((unsigned*)(ws + OFF_CNT))[otid()] = 0u;

    {
        const int* pos = (const int*)P.in[1];
        float* r64 = (float*)(ws + OFF_ROPE64); float* r128 = (float*)(ws + OFF_ROPE128);
        const double L2T = 13.287712379549449;
        for (size_t e = (size_t)obid() * NT + otid(); e < SZ * 96; e += (size_t)gridDim.x * NT) {
            const int t = (int)(e / 96), i = (int)(e % 96);
            const double ps = (double)pos[t];
            double inv; if (i < 32) inv = exp2(-(double)i * (L2T / 32.0)); else inv = exp2(-(double)(i - 32) * (L2T / 64.0));
            const double rev = ps * inv * 0.15915494309189535; const double fr = rev - rint(rev);
            const float c = __builtin_amdgcn_cosf((float)fr), s = __builtin_amdgcn_sinf((float)fr);
            if (i < 32) { r64[(size_t)t * 64 + i] = c; r64[(size_t)t * 64 + 32 + i] = s; }
            else { r128[(size_t)t * 128 + (i - 32)] = c; r128[(size_t)t * 128 + 64 + (i - 32)] = s; }
        }
    }
    cvt_job(tile, P.in[7], DM, 4192, (bf16_t*)(ws + OFF_WINE), DM, EVEN_LD, 0, 0, P.in[6]);
    cvt_job(tile, P.in[9], 512, 1536, (bf16_t*)(ws + OFF_WUQ), 512, 1536, 0, 0);
    cvt_job(tile, P.in[11], 256, 2048, (bf16_t*)(ws + OFF_WUKV), 256, 2048, 0, 0);
    cvt_job(tile, P.in[16], 64, 1024, (bf16_t*)(ws + OFF_LORA), 384, 1024, 0, 0);
    cvt_job(tile, P.in[18], 64, 1024, (bf16_t*)(ws + OFF_LORA) + (size_t)1024 * 384, 384, 1024, 64, 0);
    cvt_job(tile, P.in[19], 160, 1024, (bf16_t*)(ws + OFF_LORA) + (size_t)2048 * 384, 384, 1024, 128, 0);
    cvt_job(tile, P.in[25], DM, DM, (bf16_t*)(ws + OFF_WOUTE), DM, DM, 0, 0);
    cvt_job(tile, P.in[26], DM, 6160, (bf16_t*)(ws + OFF_WINO), DM, ODD_LD, 0, 0, P.in[6] + DM);
    cvt_gu(tile, P, 0);
    cvt_job(tile, P.in[32], DM, DM, (bf16_t*)(ws + OFF_WOUTO), DM, DM, 0, 0);
}

DEVI void eprep1(const Params& P) {
    unsigned char* ws = P.ws;
    const bf16_t* p = (const bf16_t*)(ws + E_P);
    bf16_t* cqn = (bf16_t*)(ws + E_CQN); bf16_t* ckvn = (bf16_t*)(ws + E_CKVN); bf16_t* kr = (bf16_t*)(ws + E_KR);
    bf16_t* rr = (bf16_t*)(ws + E_R); bf16_t* kb = (bf16_t*)(ws + E_KB); bf16_t* vv = (bf16_t*)(ws + E_V); bf16_t* lin = (bf16_t*)(ws + E_LIN);
    const float* qn = P.in[8]; const float* kvn = P.in[10]; const float* mu = P.in[14];
    const int wave = otid() >> 6, lane = otid() & 63;
    for (int t = obid() * 8 + wave; t < S; t += gridDim.x * 8) {
        const bf16_t* row = p + (size_t)t * EVEN_LD;
        float f[8], o[8];
        {
            unpack8(*(const u32x4*)(row + lane * 8), f);
            float ss = 0.f;
#pragma unroll
            for (int j = 0; j < 8; ++j) ss += f[j] * f[j];
            ss = wave_sum(ss); const float r = rsqrtf(ss * (1.0f / 512) + 1e-6f);
#pragma unroll
            for (int j = 0; j < 8; ++j) o[j] = f[j] * r * qn[lane * 8 + j];
            *(u32x4*)(cqn + (size_t)t * 512 + lane * 8) = pack8(o);
        }
        {
            const int l2 = lane & 31;
            unpack8(*(const u32x4*)(row + 512 + l2 * 8), f);
            float ss = 0.f;
#pragma unroll
            for (int j = 0; j < 8; ++j) ss += f[j] * f[j];
            ss = wave_sum(ss) * 0.5f; const float r = rsqrtf(ss * (1.0f / 256) + 1e-6f);
#pragma unroll
            for (int j = 0; j < 8; ++j) o[j] = f[j] * r * kvn[l2 * 8 + j];
            if (lane < 32) *(u32x4*)(ckvn + (size_t)t * 256 + l2 * 8) = pack8(o);
        }
        if (lane < 8) *(u32x4*)(kr + (size_t)t * 64 + lane * 8) = *(const u32x4*)(row + 768 + lane * 8);
        if (lane < 12) { u32x4 z = {0u, 0u, 0u, 0u}; *(u32x4*)(lin + (size_t)t * 384 + 288 + lane * 8) = z; }
#pragma unroll
        for (int it = 0; it < 7; ++it) {
            const int c8 = lane + 64 * it;
            if (c8 >= 420) continue;
            const int c = c8 * 8;
            float cur[8], prv[8];
            unpack8(*(const u32x4*)(row + 832 + c), cur);
            if (t > 0) unpack8(*(const u32x4*)(row - EVEN_LD + 832 + c), prv);
            else {
#pragma unroll
                for (int j = 0; j < 8; ++j) prv[j] = 0.f;
            }
#pragma unroll
            for (int j = 0; j < 8; ++j) o[j] = cur[j] + (prv[j] - cur[j]) * mu[c + j];
            if (c < 1024) *(u32x4*)(rr + (size_t)t * 1024 + c) = pack8(o);
            else if (c < 2048) *(u32x4*)(kb + (size_t)t * 1024 + (c - 1024)) = pack8(o);
            else if (c < 3072) *(u32x4*)(vv + (size_t)t * 1024 + (c - 2048)) = pack8(o);
            else if (c < 3136) {
#pragma unroll
                for (int j = 0; j < 8; ++j) o[j] = tanhf(o[j]);
                *(u32x4*)(lin + (size_t)t * 384 + (c - 3072)) = pack8(o);
            } else if (c < 3200) *(u32x4*)(lin + (size_t)t * 384 + 64 + (c - 3136)) = pack8(o);
            else {
#pragma unroll
                for (int j = 0; j < 8; ++j) o[j] = sigmoidf_(o[j]);
                *(u32x4*)(lin + (size_t)t * 384 + 128 + (c - 3200)) = pack8(o);
            }
        }
    }
}

DEVI void eprep2(const Params& P) {
    unsigned char* ws = P.ws;
    bf16_t* Q = (bf16_t*)(ws + E_Q); const bf16_t* kv = (const bf16_t*)(ws + E_KV); const bf16_t* kr = (const bf16_t*)(ws + E_KR); bf16_t* Km = (bf16_t*)(ws + E_K);
    const bf16_t* kb = (const bf16_t*)(ws + E_KB); const bf16_t* lout = (const bf16_t*)(ws + E_LOUT);
    float* decay = (float*)(ws + E_DECAY); bf16_t* kh = (bf16_t*)(ws + E_KH); bf16_t* na = (bf16_t*)(ws + E_NA); bf16_t* bb = (bf16_t*)(ws + E_BB);
    const float* rope = (const float*)(ws + OFF_ROPE64);
    const float* qhn = P.in[12]; const float* khn = P.in[13];
    const float* w0 = P.in[15]; const float* a0 = P.in[17]; const float* k_k = P.in[20]; const float* k_a = P.in[21];
    const int wave = otid() >> 6, lane = otid() & 63;
    const int head = lane >> 3, sub = lane & 7;
    const float qscale = 0.07216878364870322f * 1.4426950408889634f;
    for (int t = obid() * 8 + wave; t < S; t += gridDim.x * 8) {
        const float* rp = rope + (size_t)t * 64;
        const int ri = 8 * (sub & 3);
        {
            bf16_t* qrow = Q + (size_t)t * 1536 + head * 192;
            float f0[8], f1[8], f2[8];
            unpack8(*(const u32x4*)(qrow + sub * 8), f0); unpack8(*(const u32x4*)(qrow + 64 + sub * 8), f1); unpack8(*(const u32x4*)(qrow + 128 + sub * 8), f2);
            float ss = 0.f;
#pragma unroll
            for (int j = 0; j < 8; ++j) ss += f0[j] * f0[j] + f1[j] * f1[j] + f2[j] * f2[j];
            ss += __shfl_xor(ss, 1); ss += __shfl_xor(ss, 2); ss += __shfl_xor(ss, 4);
            const float r = rsqrtf(ss * (1.0f / 192) + 1e-6f) * qscale;
#pragma unroll
            for (int j = 0; j < 8; ++j) { f0[j] *= r * qhn[sub * 8 + j]; f1[j] *= r * qhn[64 + sub * 8 + j]; f2[j] *= r * qhn[128 + sub * 8 + j]; }
            float o2[8];
#pragma unroll
            for (int j = 0; j < 8; ++j) { const float other = __shfl_xor(f2[j], 4); const float c = rp[ri + j], s = rp[32 + ri + j];
                o2[j] = (sub < 4) ? (f2[j] * c - other * s) : (other * s + f2[j] * c); }
            *(u32x4*)(qrow + sub * 8) = pack8(f0); *(u32x4*)(qrow + 64 + sub * 8) = pack8(f1); *(u32x4*)(qrow + 128 + sub * 8) = pack8(o2);
        }
        {
            const bf16_t* kvrow = kv + (size_t)t * 2048 + head * 256;
            float f0[8], f1[8], f2[8];
            unpack8(*(const u32x4*)(kvrow + sub * 8), f0); unpack8(*(const u32x4*)(kvrow + 64 + sub * 8), f1); unpack8(*(const u32x4*)(kr + (size_t)t * 64 + sub * 8), f2);
            float ss = 0.f;
#pragma unroll
            for (int j = 0; j < 8; ++j) ss += f0[j] * f0[j] + f1[j] * f1[j] + f2[j] * f2[j];
            ss += __shfl_xor(ss, 1); ss += __shfl_xor(ss, 2); ss += __shfl_xor(ss, 4);
            const float r = rsqrtf(ss * (1.0f / 192) + 1e-6f);
#pragma unroll
            for (int j = 0; j < 8; ++j) { f0[j] *= r * khn[sub * 8 + j]; f1[j] *= r * khn[64 + sub * 8 + j]; f2[j] *= r * khn[128 + sub * 8 + j]; }
            float o2[8];
#pragma unroll
            for (int j = 0; j < 8; ++j) { const float other = __shfl_xor(f2[j], 4); const float c = rp[ri + j], s = rp[32 + ri + j];
                o2[j] = (sub < 4) ? (f2[j] * c - other * s) : (other * s + f2[j] * c); }
            bf16_t* krow = Km + (size_t)t * 1536 + head * 192;
            *(u32x4*)(krow + sub * 8) = pack8(f0); *(u32x4*)(krow + 64 + sub * 8) = pack8(f1); *(u32x4*)(krow + 128 + sub * 8) = pack8(o2);
        }
#pragma unroll
        for (int q = 0; q < 2; ++q) {
            const int c = (lane + 64 * q) * 8; const size_t o = (size_t)t * 1024 + c;
            float kbv[8], wl[8], al[8], dec[8], khv[8], nav[8], bbv[8];
            unpack8(*(const u32x4*)(kb + o), kbv); unpack8(*(const u32x4*)(lout + (size_t)t * 3072 + c), wl); unpack8(*(const u32x4*)(lout + (size_t)t * 3072 + 1024 + c), al);
            float nn = 0.f;
#pragma unroll
            for (int j = 0; j < 8; ++j) {
                const float x = -(w0[c + j] + wl[j]);
                const float sp = (x > 20.f) ? x : __logf(1.0f + __expf(x));
                dec[j] = __expf(-__expf(-sp - 0.5f));
                al[j] = sigmoidf_(a0[c + j] + al[j]);
                wl[j] = kbv[j] * k_k[c + j]; nn += wl[j] * wl[j];
            }
            nn += __shfl_xor(nn, 1); nn += __shfl_xor(nn, 2); nn += __shfl_xor(nn, 4);
            const float rn = __builtin_amdgcn_rcpf(fmaxf(__builtin_amdgcn_sqrtf(nn), 1e-12f));
#pragma unroll
            for (int j = 0; j < 8; ++j) { const float kk = wl[j] * rn; khv[j] = kbv[j] * (1.0f + (al[j] - 1.0f) * k_a[c + j]); nav[j] = -kk; bbv[j] = kk * al[j]; }
            *(f32x4*)(decay + o) = (f32x4){dec[0], dec[1], dec[2], dec[3]}; *(f32x4*)(decay + o + 4) = (f32x4){dec[4], dec[5], dec[6], dec[7]};
            *(u32x4*)(kh + o) = pack8(khv); *(u32x4*)(na + o) = pack8(nav); *(u32x4*)(bb + o) = pack8(bbv);
        }
    }
}

template <int DQK> struct AttnCfg { static constexpr int KSTR = DQK * 2 + 16, VSTR = 320, KB = 64 * KSTR, VB = 64 * VSTR, VOFF = 2 * KB, NKC = DQK / 64; };
template <int DQK, int MODE>
DEVI void attn_item(LAS unsigned char* lds, const bf16_t* Qh, int qs, const bf16_t* Kh, int ks_, const bf16_t* Vh, int vs, bf16_t* Oh, int os,
                    float* lse, int lses, int i0, int dil, int res) {
    typedef AttnCfg<DQK> C;
    const int tid = otid(), wave = tid >> 6, lane = tid & 63, l31 = lane & 31, hh = lane >> 5;
    const bool grpB = __builtin_amdgcn_readfirstlane(wave) >= 4;
    const int qidx = i0 + 32 * wave + l31;
    bf16x8 qf[DQK / 16];
    { const bf16_t* qrow = Qh + (size_t)(res + dil * qidx) * qs;
#pragma unroll
      for (int k = 0; k < DQK / 16; ++k) qf[k] = *(const bf16x8*)(qrow + 16 * k + 8 * hh);
#pragma unroll
      for (int k = 0; k < DQK / 16; ++k) asm volatile("" : "+v"(qf[k]));
    }
    const int kbase = MODE ? (i0 - 128) : 0;
    const int j0 = (MODE && kbase < 0) ? 2 : 0;
    const int j1 = MODE ? 6 : (i0 / 64 + 4);
    f32x16 O[4];
#pragma unroll
    for (int c = 0; c < 4; ++c)
#pragma unroll
        for (int j = 0; j < 16; ++j) O[c][j] = 0.f;
    float mrun = -1e30f, lrun = 0.f;
    u32x4 kreg[C::NKC], vreg[2];
    u32x4 pk[4];
#pragma unroll
    for (int i = 0; i < 4; ++i) pk[i] = (u32x4){0u, 0u, 0u, 0u};
    auto gload = [&](int jt) {
        const int kb0 = kbase + 64 * jt;
#pragma unroll
        for (int u = 0; u < C::NKC; ++u) { const int id = tid + NT * u, row = id / (DQK / 8), cc = id % (DQK / 8);
            kreg[u] = *(const u32x4*)(Kh + (size_t)(res + dil * (kb0 + row)) * ks_ + cc * 8); }
#pragma unroll
        for (int u = 0; u < 2; ++u) { const int id = tid + NT * u, row = id >> 4, cc = id & 15;
            vreg[u] = *(const u32x4*)(Vh + (size_t)(res + dil * (kb0 + row)) * vs + cc * 8); }
    };
    auto lstore = [&](int kbi, int vbi) {
        LAS unsigned char* kb_ = lds + kbi * C::KB; LAS unsigned char* vb_ = lds + C::VOFF + vbi * C::VB;
#pragma unroll
        for (int u = 0; u < C::NKC; ++u) { const int id = tid + NT * u, row = id / (DQK / 8), cc = id % (DQK / 8);
            *(LAS u32x4*)(kb_ + row * C::KSTR + cc * 16) = kreg[u]; }
#pragma unroll
        for (int u = 0; u < 2; ++u) { const int id = tid + NT * u, row = id >> 4, cc = id & 15;
            *(LAS u32x4*)(vb_ + row * C::VSTR + cc * 16) = vreg[u]; }
    };
    const int vq = (lane & 15) >> 2, vp = lane & 3, vblk = (lane >> 4) & 1;
    auto pv = [&](int vbi) {
        const LAS unsigned char* vbuf = lds + C::VOFF + vbi * C::VB + (4 * hh + vq) * C::VSTR + (16 * vblk + 4 * vp) * 2;
        auto vld = [&](int i) {
            const int sl = i >> 2, c = i & 3;
            const LAS unsigned char* a = vbuf + (32 * (sl >> 1) + 16 * (sl & 1)) * C::VSTR + 64 * c;
            const s16x4 t0 = __builtin_amdgcn_ds_read_tr16_b64_v4i16((LAS s16x4*)a);
            const s16x4 t1 = __builtin_amdgcn_ds_read_tr16_b64_v4i16((LAS s16x4*)(a + 8 * C::VSTR));
            bf16x8 vf; vf[0] = t0[0]; vf[1] = t0[1]; vf[2] = t0[2]; vf[3] = t0[3]; vf[4] = t1[0]; vf[5] = t1[1]; vf[6] = t1[2]; vf[7] = t1[3];
            return vf;
        };
        bf16x8 fv[3];
        __builtin_amdgcn_s_setprio(1);
        fv[0] = vld(0); fv[1] = vld(1);
        __builtin_amdgcn_sched_barrier(0);
#pragma unroll
        for (int i = 0; i < 16; ++i) {
            if (i + 2 < 16) fv[(i + 2) % 3] = vld(i + 2);
            __builtin_amdgcn_sched_barrier(0);
            bf16x8 pf; __builtin_memcpy(&pf, &pk[i >> 2], 16);
            O[i & 3] = __builtin_amdgcn_mfma_f32_32x32x16_bf16(fv[i % 3], pf, O[i & 3], 0, 0, 0);
            __builtin_amdgcn_sched_barrier(0);
        }
        __builtin_amdgcn_s_setprio(0);
    };
    gload(j0); lstore(0, 0); __syncthreads();
    const int qw0 = i0 + 32 * wave;
    bool havePrev = false;
    int kbi = 0, vbi = 0;
    for (int jt = j0; jt < j1; ++jt) {
        if (jt + 1 < j1) gload(jt + 1);
        const int vprev = vbi == 0 ? 2 : vbi - 1;
        if (grpB && havePrev) pv(vprev);
        havePrev = false;
        const int kb0 = kbase + 64 * jt;
        bool need = kb0 <= qw0 + 31;
        if (MODE) need = need && (kb0 + 63 >= qw0 - 128);
        if (need) {
            const LAS unsigned char* kbuf = lds + kbi * C::KB;
            f32x16 s0, s1;
#pragma unroll
            for (int j = 0; j < 16; ++j) { s0[j] = 0.f; s1[j] = 0.f; }
            {
                constexpr int NK = DQK / 16;
                const LAS unsigned char* kp0 = kbuf + l31 * C::KSTR + 16 * hh;
                const LAS unsigned char* kp1 = kp0 + 32 * C::KSTR;
                bf16x8 fa[3][2];
                __builtin_amdgcn_s_setprio(1);
#pragma unroll
                for (int k = 0; k < 2; ++k) { fa[k][0] = *(const LAS bf16x8*)(kp0 + 32 * k); fa[k][1] = *(const LAS bf16x8*)(kp1 + 32 * k); }
                __builtin_amdgcn_sched_barrier(0);
#pragma unroll
                for (int k = 0; k < NK; ++k) {
                    if (k + 2 < NK) { fa[(k + 2) % 3][0] = *(const LAS bf16x8*)(kp0 + 32 * (k + 2)); fa[(k + 2) % 3][1] = *(const LAS bf16x8*)(kp1 + 32 * (k + 2)); }
                    __builtin_amdgcn_sched_barrier(0);
                    s0 = __builtin_amdgcn_mfma_f32_32x32x16_bf16(fa[k % 3][0], qf[k], s0, 0, 0, 0);
                    s1 = __builtin_amdgcn_mfma_f32_32x32x16_bf16(fa[k % 3][1], qf[k], s1, 0, 0, 0);
                    __builtin_amdgcn_sched_barrier(0);
                }
                __builtin_amdgcn_s_setprio(0);
            }
            const bool domask = MODE ? !(kb0 + 63 <= qw0 && kb0 >= qw0 + 31 - 128) : (kb0 + 63 > qw0);
            if (domask) {
#pragma unroll
                for (int j = 0; j < 16; ++j) { const int key0 = kb0 + 8 * (j >> 2) + 4 * hh + (j & 3), key1 = key0 + 32;
                    bool v0 = key0 <= qidx, v1 = key1 <= qidx;
                    if (MODE) { v0 = v0 && (key0 >= qidx - 128); v1 = v1 && (key1 >= qidx - 128); }
                    s0[j] = v0 ? s0[j] : -1e30f; s1[j] = v1 ? s1[j] : -1e30f; }
            }
            float mx = s0[0];
#pragma unroll
            for (int j = 0; j < 16; ++j) asm("v_max3_f32 %0, %0, %1, %2" : "+v"(mx) : "v"(s0[j]), "v"(s1[j]));
            { const u32x2 sw = __builtin_amdgcn_permlane32_swap(__float_as_uint(mx), __float_as_uint(mx), false, false);
              mx = fmaxf(__uint_as_float(sw[0]), __uint_as_float(sw[1])); }
            const float mnew = fmaxf(mrun, mx);
            const float alpha = __builtin_amdgcn_exp2f(mrun - mnew);
            mrun = mnew;
            const float msafe = fmaxf(mnew, -1e29f);
            float ls = 0.f;
#pragma unroll
            for (int j = 0; j < 16; ++j) { const float p0 = __builtin_amdgcn_exp2f(s0[j] - msafe), p1 = __builtin_amdgcn_exp2f(s1[j] - msafe);
                s0[j] = p0; s1[j] = p1; ls += p0 + p1; }
            lrun = lrun * alpha + ls;
#pragma unroll
            for (int c = 0; c < 4; ++c)
#pragma unroll
                for (int j = 0; j < 16; ++j) O[c][j] *= alpha;
            pk[0] = (u32x4){pk_bf16(s0[0], s0[1]), pk_bf16(s0[2], s0[3]), pk_bf16(s0[4], s0[5]), pk_bf16(s0[6], s0[7])};
            pk[1] = (u32x4){pk_bf16(s0[8], s0[9]), pk_bf16(s0[10], s0[11]), pk_bf16(s0[12], s0[13]), pk_bf16(s0[14], s0[15])};
            pk[2] = (u32x4){pk_bf16(s1[0], s1[1]), pk_bf16(s1[2], s1[3]), pk_bf16(s1[4], s1[5]), pk_bf16(s1[6], s1[7])};
            pk[3] = (u32x4){pk_bf16(s1[8], s1[9]), pk_bf16(s1[10], s1[11]), pk_bf16(s1[12], s1[13]), pk_bf16(s1[14], s1[15])};
            if (!grpB) pv(vbi); else havePrev = true;
        }
        const int kn = kbi ^ 1, vn = vbi == 2 ? 0 : vbi + 1;
        if (jt + 1 < j1) lstore(kn, vn);
        __syncthreads();
        kbi = kn; vbi = vn;
    }
    if (grpB && havePrev) pv(vbi == 0 ? 2 : vbi - 1);
    const float ltot = lrun + __shfl_xor(lrun, 32);
    const float inv = __builtin_amdgcn_rcpf(ltot);
    bf16_t* orow = Oh + (size_t)(res + dil * qidx) * os;
#pragma unroll
    for (int c = 0; c < 4; ++c)
#pragma unroll
        for (int g = 0; g < 4; ++g) { u32x2 w; w.x = pk_bf16(O[c][4 * g] * inv, O[c][4 * g + 1] * inv); w.y = pk_bf16(O[c][4 * g + 2] * inv, O[c][4 * g + 3] * inv);
            *(u32x2*)(orow + 32 * c + 8 * g + 4 * hh) = w; }
    if (lse != nullptr && hh == 0) lse[(size_t)(res + dil * qidx) * lses] = mrun + __builtin_amdgcn_logf(ltot);
}

DEVI float dpp_xor1(float v) { return __int_as_float(__builtin_amdgcn_update_dpp(0, __float_as_int(v), 0xB1, 0xF, 0xF, false)); }
DEVI float dpp_xor2(float v) { return __int_as_float(__builtin_amdgcn_update_dpp(0, __float_as_int(v), 0x4E, 0xF, 0xF, false)); }
constexpr int RW_L = 256, RW_NC = S / RW_L, RW_T = 16, RW_STEPB = 6 * 64 * 4, RW_STAGEB = RW_T * RW_STEPB;
struct RwRegs { f32x4 w0, w1; u32x4 a, b, k, r, v; };
DEVI void rw_gload(RwRegs& R, const Params& P, int head, int t0, int p) {
    unsigned char* ws = P.ws;
    const size_t o = (size_t)(t0 + (p >> 3)) * 1024 + head * 64 + (p & 7) * 8;
    R.w0 = *(const f32x4*)((const float*)(ws + E_DECAY) + o); R.w1 = *(const f32x4*)((const float*)(ws + E_DECAY) + o + 4);
    R.a = *(const u32x4*)((const bf16_t*)(ws + E_NA) + o); R.b = *(const u32x4*)((const bf16_t*)(ws + E_BB) + o);
    R.k = *(const u32x4*)((const bf16_t*)(ws + E_KH) + o); R.r = *(const u32x4*)((const bf16_t*)(ws + E_R) + o); R.v = *(const u32x4*)((const bf16_t*)(ws + E_V) + o);
}
DEVI void rw_st8(LAS unsigned char* d, u32x4 u) { float f[8]; unpack8(u, f); *(LAS f32x4*)d = (f32x4){f[0], f[1], f[2], f[3]}; *(LAS f32x4*)(d + 16) = (f32x4){f[4], f[5], f[6], f[7]}; }
DEVI void rw_lstore(const RwRegs& R, LAS unsigned char* buf, int p) {
    LAS unsigned char* dst = buf + (p >> 3) * RW_STEPB + (p & 7) * 32;
    *(LAS f32x4*)(dst) = R.w0; *(LAS f32x4*)(dst + 16) = R.w1;
    rw_st8(dst + 256, R.a); rw_st8(dst + 512, R.b); rw_st8(dst + 768, R.k); rw_st8(dst + 1024, R.r); rw_st8(dst + 1280, R.v);
}
DEVI void rwkv_A(LAS unsigned char* lds, const Params& P) {
    const int tid = otid(), inst = tid >> 7, p = tid & 127, rp = p >> 2, qc = p & 3;
    float* pu = (float*)(P.ws + E_PU);
    for (int it0 = obid() * 4; it0 < 16 * RW_NC; it0 += gridDim.x * 4) {
        const int item = it0 + inst, head = item / RW_NC, chunk = item % RW_NC, tb = chunk * RW_L;
        f32x2 Pm[2][8], Um[2][8];
#pragma unroll
        for (int h = 0; h < 2; ++h)
#pragma unroll
            for (int j = 0; j < 8; ++j) { Pm[h][j] = (f32x2){(16 * qc + 2 * j == 2 * rp + h) ? 1.f : 0.f, (16 * qc + 2 * j + 1 == 2 * rp + h) ? 1.f : 0.f}; Um[h][j] = (f32x2){0.f, 0.f}; }
        LAS unsigned char* buf = lds + inst * RW_STAGEB;
        RwRegs R; rw_gload(R, P, head, tb, p);
        for (int st = 0; st < RW_L / RW_T; ++st) {
            rw_lstore(R, buf, p);
            __syncthreads();
            if (st + 1 < RW_L / RW_T) rw_gload(R, P, head, tb + (st + 1) * RW_T, p);
            const LAS unsigned char* sb = buf + qc * 64;
#pragma unroll 2
            for (int s = 0; s < RW_T; ++s) {
                const LAS unsigned char* sp = sb + s * RW_STEPB;
                f32x2 w[8], a[8], b[8], k[8];
#pragma unroll
                for (int q = 0; q < 4; ++q) {
                    const f32x4 tw = *(const LAS f32x4*)(sp + q * 16), ta = *(const LAS f32x4*)(sp + 256 + q * 16), tb_ = *(const LAS f32x4*)(sp + 512 + q * 16), tk = *(const LAS f32x4*)(sp + 768 + q * 16);
                    w[2 * q] = (f32x2){tw[0], tw[1]}; w[2 * q + 1] = (f32x2){tw[2], tw[3]}; a[2 * q] = (f32x2){ta[0], ta[1]}; a[2 * q + 1] = (f32x2){ta[2], ta[3]};
                    b[2 * q] = (f32x2){tb_[0], tb_[1]}; b[2 * q + 1] = (f32x2){tb_[2], tb_[3]}; k[2 * q] = (f32x2){tk[0], tk[1]}; k[2 * q + 1] = (f32x2){tk[2], tk[3]};
                }
                const LAS float* vp = (const LAS float*)(sp - qc * 64 + 1280 + rp * 8);
                const float vi[2] = {vp[0], vp[1]};
#pragma unroll
                for (int h = 0; h < 2; ++h) {
                    f32x2 ap = {0.f, 0.f}, au = {0.f, 0.f};
#pragma unroll
                    for (int j = 0; j < 8; ++j) { ap = __builtin_elementwise_fma(Pm[h][j], a[j], ap); au = __builtin_elementwise_fma(Um[h][j], a[j], au); }
                    float sp_ = ap[0] + ap[1], su = au[0] + au[1];
                    sp_ += dpp_xor1(sp_); su += dpp_xor1(su); sp_ += dpp_xor2(sp_); su += dpp_xor2(su);
                    const f32x2 sp2 = {sp_, sp_}, su2 = {su, su}, v2 = {vi[h], vi[h]};
#pragma unroll
                    for (int j = 0; j < 8; ++j) { Pm[h][j] = __builtin_elementwise_fma(Pm[h][j], w[j], sp2 * b[j]);
                        Um[h][j] = __builtin_elementwise_fma(Um[h][j], w[j], __builtin_elementwise_fma(su2, b[j], v2 * k[j])); }
                }
            }
            __syncthreads();
        }
#pragma unroll
        for (int h = 0; h < 2; ++h) {
            float* po = pu + ((size_t)item * 2) * 4096 + (2 * rp + h) * 64 + qc * 16;
#pragma unroll
            for (int q = 0; q < 4; ++q) { *(f32x4*)(po + q * 4) = (f32x4){Pm[h][2 * q][0], Pm[h][2 * q][1], Pm[h][2 * q + 1][0], Pm[h][2 * q + 1][1]};
                *(f32x4*)(po + 4096 + q * 4) = (f32x4){Um[h][2 * q][0], Um[h][2 * q][1], Um[h][2 * q + 1][0], Um[h][2 * q + 1][1]}; }
        }
    }
}
DEVI void rwkv_B(LAS unsigned char* lds, const Params& P, int head) {
    const int tid = otid(), i = tid >> 3, jg = tid & 7;
    const float* pu = (const float*)(P.ws + E_PU); float* sin = (float*)(P.ws + E_SIN);
    LAS float* Sl = (LAS float*)lds;
    LAS float* Pl = (LAS float*)(lds + 64 * 65 * 4);
    float cur[8];
#pragma unroll
    for (int e = 0; e < 8; ++e) { cur[e] = 0.f; Sl[i * 65 + 8 * jg + e] = 0.f; }
    for (int c = 0; c < RW_NC; ++c) {
        const size_t item = (size_t)head * RW_NC + c;
        float* so = sin + item * 4096 + i * 64 + 8 * jg;
        *(f32x4*)so = (f32x4){cur[0], cur[1], cur[2], cur[3]}; *(f32x4*)(so + 4) = (f32x4){cur[4], cur[5], cur[6], cur[7]};
        const float* pc = pu + item * 2 * 4096;
#pragma unroll
        for (int u = 0; u < 2; ++u) { const int id = tid + NT * u; *(LAS f32x4*)(Pl + id * 4) = *(const f32x4*)(pc + id * 4); }
        const f32x4 u0 = *(const f32x4*)(pc + 4096 + i * 64 + 8 * jg), u1 = *(const f32x4*)(pc + 4096 + i * 64 + 8 * jg + 4);
        float acc[8] = {u0[0], u0[1], u0[2], u0[3], u1[0], u1[1], u1[2], u1[3]};
        __syncthreads();
#pragma unroll 8
        for (int k = 0; k < 64; ++k) { const float s = Sl[i * 65 + k]; const f32x4 p0 = *(const LAS f32x4*)(Pl + k * 64 + 8 * jg), p1 = *(const LAS f32x4*)(Pl + k * 64 + 8 * jg + 4);
            acc[0] += s * p0[0]; acc[1] += s * p0[1]; acc[2] += s * p0[2]; acc[3] += s * p0[3]; acc[4] += s * p1[0]; acc[5] += s * p1[1]; acc[6] += s * p1[2]; acc[7] += s * p1[3]; }
        __syncthreads();
#pragma unroll
        for (int e = 0; e < 8; ++e) { cur[e] = acc[e]; Sl[i * 65 + 8 * jg + e] = acc[e]; }
        __syncthreads();
    }
}
DEVI void rwkv_C(LAS unsigned char* lds, const Params& P) {
    const int tid = otid(), inst = tid >> 7, p = tid & 127, rp = p >> 2, qc = p & 3;
    const float* sin = (const float*)(P.ws + E_SIN); bf16_t* y = (bf16_t*)(P.ws + E_Y);
    for (int it0 = obid() * 4; it0 < 16 * RW_NC; it0 += gridDim.x * 4) {
        const int item = it0 + inst, head = item / RW_NC, chunk = item % RW_NC, tb = chunk * RW_L;
        f32x2 St[2][8];
#pragma unroll
        for (int h = 0; h < 2; ++h) { const float* si = sin + (size_t)item * 4096 + (2 * rp + h) * 64 + qc * 16;
#pragma unroll
          for (int q = 0; q < 4; ++q) { const f32x4 x = *(const f32x4*)(si + q * 4); St[h][2 * q] = (f32x2){x[0], x[1]}; St[h][2 * q + 1] = (f32x2){x[2], x[3]}; } }
        LAS unsigned char* buf = lds + inst * RW_STAGEB;
        LAS float* yb = (LAS float*)(lds + 4 * RW_STAGEB + inst * RW_T * 256);
        RwRegs R; rw_gload(R, P, head, tb, p);
        for (int st = 0; st < RW_L / RW_T; ++st) {
            rw_lstore(R, buf, p);
            __syncthreads();
            if (st + 1 < RW_L / RW_T) rw_gload(R, P, head, tb + (st + 1) * RW_T, p);
            const LAS unsigned char* sb = buf + qc * 64;
#pragma unroll 2
            for (int s = 0; s < RW_T; ++s) {
                const LAS unsigned char* sp = sb + s * RW_STEPB;
                f32x2 w[8], a[8], b[8], k[8], r[8];
#pragma unroll
                for (int q = 0; q < 4; ++q) {
                    const f32x4 tw = *(const LAS f32x4*)(sp + q * 16), ta = *(const LAS f32x4*)(sp + 256 + q * 16), tb_ = *(const LAS f32x4*)(sp + 512 + q * 16),
                                tk = *(const LAS f32x4*)(sp + 768 + q * 16), tr = *(const LAS f32x4*)(sp + 1024 + q * 16);
                    w[2 * q] = (f32x2){tw[0], tw[1]}; w[2 * q + 1] = (f32x2){tw[2], tw[3]}; a[2 * q] = (f32x2){ta[0], ta[1]}; a[2 * q + 1] = (f32x2){ta[2], ta[3]};
                    b[2 * q] = (f32x2){tb_[0], tb_[1]}; b[2 * q + 1] = (f32x2){tb_[2], tb_[3]}; k[2 * q] = (f32x2){tk[0], tk[1]}; k[2 * q + 1] = (f32x2){tk[2], tk[3]};
                    r[2 * q] = (f32x2){tr[0], tr[1]}; r[2 * q + 1] = (f32x2){tr[2], tr[3]};
                }
                const LAS float* vp = (const LAS float*)(sp - qc * 64 + 1280 + rp * 8);
                const float vi[2] = {vp[0], vp[1]};
                float yy[2];
#pragma unroll
                for (int h = 0; h < 2; ++h) {
                    f32x2 as = {0.f, 0.f};
#pragma unroll
                    for (int j = 0; j < 8; ++j) as = __builtin_elementwise_fma(St[h][j], a[j], as);
                    float sa = as[0] + as[1];
                    sa += dpp_xor1(sa); sa += dpp_xor2(sa);
                    const f32x2 sa2 = {sa, sa}, v2 = {vi[h], vi[h]};
                    f32x2 ay = {0.f, 0.f};
#pragma unroll
                    for (int j = 0; j < 8; ++j) { St[h][j] = __builtin_elementwise_fma(St[h][j], w[j], __builtin_elementwise_fma(sa2, b[j], v2 * k[j])); ay = __builtin_elementwise_fma(St[h][j], r[j], ay); }
                    float t_ = ay[0] + ay[1];
                    t_ += dpp_xor1(t_); t_ += dpp_xor2(t_);
                    yy[h] = t_;
                }
                if (qc == 0) { yb[s * 64 + 2 * rp] = yy[0]; yb[s * 64 + 2 * rp + 1] = yy[1]; }
            }
            __syncthreads();
            { const LAS float* ys = yb + (p >> 3) * 64 + (p & 7) * 8; float f[8];
#pragma unroll
              for (int j = 0; j < 8; ++j) f[j] = ys[j];
              *(u32x4*)(y + (size_t)(tb + st * RW_T + (p >> 3)) * 1024 + head * 64 + (p & 7) * 8) = pack8(f); }
        }
    }
}

DEVI void emix(LAS unsigned char* lds, const Params& P) {
    unsigned char* ws = P.ws;
    if (obid() < 16) { rwkv_B(lds, P, obid()); }
    unsigned* cnt = (unsigned*)(ws + OFF_CNT) + 32;
    LAS int* slot = (LAS int*)(lds + LDS_BYTES - 16);
    const bf16_t* Q = (const bf16_t*)(ws + E_Q); const bf16_t* Km = (const bf16_t*)(ws + E_K); const bf16_t* kv = (const bf16_t*)(ws + E_KV);
    bf16_t* mix = (bf16_t*)(ws + OFF_XN);
    const int xcd = (int)(xb_xcc_id() & 7u);
    for (;;) {
        if (otid() == 0) { int hsel = -1, nsel = 0;
            for (int k = 0; k < 8; ++k) { const int h = (xcd + k) & 7; const int n = (int)atomicAdd(cnt + h, 1u); if (n < 64) { hsel = h; nsel = n; break; } }
            slot[0] = hsel; slot[1] = nsel; }
        __syncthreads();
        const int head = slot[0], n = slot[1];
        __syncthreads();
        if (head < 0) break;
        const int qb = 63 - n;
        attn_item<192, 0>(lds, Q + head * 192, 1536, Km + head * 192, 1536, kv + head * 256 + 128, 2048, mix + head * 128, 2048, nullptr, 0, qb * 256, 1, 0);
    }
}

DEVI void epost(const Params& P) {
    unsigned char* ws = P.ws;
    const bf16_t* y = (const bf16_t*)(ws + E_Y); const bf16_t* rr = (const bf16_t*)(ws + E_R); const bf16_t* kh = (const bf16_t*)(ws + E_KH); const bf16_t* vv = (const bf16_t*)(ws + E_V);
    const bf16_t* lout = (const bf16_t*)(ws + E_LOUT); bf16_t* mix = (bf16_t*)(ws + OFF_XN);
    const float* r_k = P.in[22]; const float* ln_w = P.in[23]; const float* ln_b = P.in[24];
    const int wave = otid() >> 6, lane = otid() & 63;
    for (int t = obid() * 8 + wave; t < S; t += gridDim.x * 8) {
#pragma unroll
        for (int q = 0; q < 2; ++q) {
            const int c = (lane + 64 * q) * 8; const size_t o = (size_t)t * 1024 + c;
            float yv[8], rv[8], kv_[8], v[8], g[8], ov[8];
            unpack8(*(const u32x4*)(y + o), yv); unpack8(*(const u32x4*)(rr + o), rv); unpack8(*(const u32x4*)(kh + o), kv_); unpack8(*(const u32x4*)(vv + o), v);
            unpack8(*(const u32x4*)(lout + (size_t)t * 3072 + 2048 + c), g);
            float s1 = 0.f, s3 = 0.f;
#pragma unroll
            for (int j = 0; j < 8; ++j) { s1 += yv[j]; s3 += rv[j] * kv_[j] * r_k[c + j]; }
            s1 += __shfl_xor(s1, 1); s3 += __shfl_xor(s3, 1); s1 += __shfl_xor(s1, 2); s3 += __shfl_xor(s3, 2); s1 += __shfl_xor(s1, 4); s3 += __shfl_xor(s3, 4);
            const float mean = s1 * (1.0f / 64);
            float s2 = 0.f;
#pragma unroll
            for (int j = 0; j < 8; ++j) { yv[j] -= mean; s2 += yv[j] * yv[j]; }
            s2 += __shfl_xor(s2, 1); s2 += __shfl_xor(s2, 2); s2 += __shfl_xor(s2, 4);
            const float rs = rsqrtf(s2 * (1.0f / 64) + 64e-5f);
#pragma unroll
            for (int j = 0; j < 8; ++j) ov[j] = ((yv[j] * rs * ln_w[c + j] + ln_b[c + j]) + s3 * v[j]) * g[j];
            *(u32x4*)(mix + (size_t)t * 2048 + 1024 + c) = pack8(ov);
        }
    }
}

DEVI void oprep(const Params& P) {
    unsigned char* ws = P.ws;
    bf16_t* p = (bf16_t*)(ws + O_P); float* lg = (float*)(ws + O_LG);
    const float* rope = (const float*)(ws + OFF_ROPE128);
    const float* qhn = P.in[27]; const float* khn = P.in[28]; const float* wgu = P.in[29]; const float* bg = P.in[30];
    const int wave = otid() >> 6, lane = otid() & 63, head = lane >> 3, sub = lane & 7;
    const float qscale = 0.08838834764831845f * 1.4426950408889634f;
    for (int t = obid() * 8 + wave; t < S; t += gridDim.x * 8) {
        bf16_t* row = p + (size_t)t * ODD_LD;
        const float* rp = rope + (size_t)t * 128;
#pragma unroll
        for (int which = 0; which < 2; ++which) {
            bf16_t* hrow = row + which * 1024 + head * 128;
            const float* nw = which ? khn : qhn;
            float f0[8], f1[8], o0[8], o1[8];
            unpack8(*(const u32x4*)(hrow + sub * 8), f0); unpack8(*(const u32x4*)(hrow + 64 + sub * 8), f1);
            float ss = 0.f;
#pragma unroll
            for (int j = 0; j < 8; ++j) ss += f0[j] * f0[j] + f1[j] * f1[j];
            ss += __shfl_xor(ss, 1); ss += __shfl_xor(ss, 2); ss += __shfl_xor(ss, 4);
            const float r = rsqrtf(ss * (1.0f / 128) + 1e-6f) * (which ? 1.0f : qscale);
#pragma unroll
            for (int j = 0; j < 8; ++j) { const float x1 = f0[j] * r * nw[sub * 8 + j], x2 = f1[j] * r * nw[64 + sub * 8 + j];
                const float c = rp[sub * 8 + j], s = rp[64 + sub * 8 + j];
                o0[j] = x1 * c - x2 * s; o1[j] = x1 * s + x2 * c; }
            *(u32x4*)(hrow + sub * 8) = pack8(o0); *(u32x4*)(hrow + 64 + sub * 8) = pack8(o1);
        }
        float gl[16];
        { float a[8], b[8]; unpack8(*(const u32x4*)(row + 5120), a); unpack8(*(const u32x4*)(row + 5128), b);
#pragma unroll
          for (int j = 0; j < 8; ++j) { gl[j] = a[j]; gl[8 + j] = b[j]; } }
#pragma unroll
        for (int q = 0; q < 2; ++q) {
            const int c0 = (lane + 64 * q) * 4;
            f32x4 acc = *(const f32x4*)(bg + c0);
#pragma unroll
            for (int j = 0; j < 16; ++j) { const f32x4 w = *(const f32x4*)(wgu + j * 512 + c0); acc += w * gl[j]; }
            f32x4 o;
#pragma unroll
            for (int e = 0; e < 4; ++e) { const float x = acc[e]; const float ls = fminf(x, 0.f) - __logf(1.0f + __expf(-fabsf(x))); o[e] = ls * (1.0f / 16); }
            *(f32x4*)(lg + (size_t)t * 512 + c0) = o;
        }
    }
}

DEVI bf16x8 frag_rm(const LAS unsigned char* base, int ld, int m0, int k0, int lane) {
    return *(const LAS bf16x8*)(base + (m0 + (lane & 31)) * ld + (k0 + 8 * (lane >> 5)) * 2);
}
DEVI bf16x8 frag_tr(const LAS unsigned char* base, int ld, int k0, int m0, int lane) {
    const int h = lane >> 5, blk = (lane >> 4) & 1, q = (lane & 15) >> 2, p = lane & 3;
    const LAS unsigned char* a = base + (k0 + 8 * h + q) * ld + (m0 + 16 * blk + 4 * p) * 2;
    const s16x4 t0 = __builtin_amdgcn_ds_read_tr16_b64_v4i16((LAS s16x4*)a);
    const s16x4 t1 = __builtin_amdgcn_ds_read_tr16_b64_v4i16((LAS s16x4*)(a + 4 * ld));
    bf16x8 v; v[0] = t0[0]; v[1] = t0[1]; v[2] = t0[2]; v[3] = t0[3]; v[4] = t1[0]; v[5] = t1[1]; v[6] = t1[2]; v[7] = t1[3];
    return v;
}

constexpr int G_QS = 0, G_KS = 17408, G_VS = 34816, G_SS = 68608, G_AS = 136192;
constexpr int G_LDQ = 272, G_LDV = 528, G_LDA = 144;
DEVI void gla_bcum(LAS unsigned char* lds, const float* lg, int chunk, int head) {
    LAS float* L = (LAS float*)(lds + G_SS);
    const int tid = otid();
#pragma unroll
    for (int u = 0; u < 4; ++u) { const int id = tid + NT * u, row = id >> 5, c4 = id & 31;
        *(LAS f32x4*)(L + row * 128 + c4 * 4) = *(const f32x4*)(lg + (size_t)(chunk * 64 + row) * 512 + head * 128 + c4 * 4); }
    __syncthreads();
    if (tid < 128) { float run = 0.f;
        for (int s = 0; s < 64; ++s) { run += L[s * 128 + tid]; L[s * 128 + tid] = run; } }
    __syncthreads();
}
DEVI void gla_load_v(LAS unsigned char* lds, const bf16_t* p, int chunk, int head) {
    const int tid = otid();
#pragma unroll
    for (int u = 0; u < 4; ++u) { const int id = tid + NT * u, row = id >> 5, cc = id & 31;
        *(LAS u32x4*)(lds + G_VS + row * G_LDV + cc * 16) = *(const u32x4*)(p + (size_t)(chunk * 64 + row) * ODD_LD + 4096 + head * 256 + cc * 8); }
}
DEVI void gla_local(LAS unsigned char* lds, const Params& P, int item) {
    unsigned char* ws = P.ws;
    const bf16_t* p = (const bf16_t*)(ws + O_P); const float* lg = (const float*)(ws + O_LG);
    float* ust = (float*)(ws + O_UST); float* dvec = (float*)(ws + O_DVEC);
    const int chunk = item >> 2, head = item & 3, tid = otid(), wave = tid >> 6, lane = tid & 63;
    gla_bcum(lds, lg, chunk, head);
    const LAS float* L = (const LAS float*)(lds + G_SS);
    gla_load_v(lds, p, chunk, head);
#pragma unroll
    for (int u = 0; u < 2; ++u) { const int id = tid + NT * u, row = id >> 4, cc = id & 15;
        float f[8]; unpack8(*(const u32x4*)(p + (size_t)(chunk * 64 + row) * ODD_LD + 3584 + head * 128 + cc * 8), f);
#pragma unroll
        for (int j = 0; j < 8; ++j) f[j] *= __expf(L[63 * 128 + cc * 8 + j] - L[row * 128 + cc * 8 + j]);
        *(LAS u32x4*)(lds + G_KS + row * G_LDQ + cc * 16) = pack8(f); }
    if (tid < 128) dvec[(size_t)item * 128 + tid] = __expf(L[63 * 128 + tid]);
    __syncthreads();
    const int mt = wave & 3, nb = (wave >> 2) * 4;
    f32x16 acc[4];
#pragma unroll
    for (int n = 0; n < 4; ++n)
#pragma unroll
        for (int j = 0; j < 16; ++j) acc[n][j] = 0.f;
    {
        bf16x8 fa[2], fb[2][4];
        fa[0] = frag_tr(lds + G_KS, G_LDQ, 0, 32 * mt, lane);
#pragma unroll
        for (int n = 0; n < 4; ++n) fb[0][n] = frag_tr(lds + G_VS, G_LDV, 0, 32 * (nb + n), lane);
        __builtin_amdgcn_sched_barrier(0);
#pragma unroll
        for (int ks = 0; ks < 4; ++ks) {
            if (ks + 1 < 4) { fa[(ks + 1) & 1] = frag_tr(lds + G_KS, G_LDQ, 16 * (ks + 1), 32 * mt, lane);
#pragma unroll
                for (int n = 0; n < 4; ++n) fb[(ks + 1) & 1][n] = frag_tr(lds + G_VS, G_LDV, 16 * (ks + 1), 32 * (nb + n), lane); }
            __builtin_amdgcn_sched_barrier(0);
#pragma unroll
            for (int n = 0; n < 4; ++n) acc[n] = __builtin_amdgcn_mfma_f32_32x32x16_bf16(fa[ks & 1], fb[ks & 1][n], acc[n], 0, 0, 0);
            __builtin_amdgcn_sched_barrier(0);
        }
    }
    float* ub = ust + (size_t)item * 128 * 256;
#pragma unroll
    for (int n = 0; n < 4; ++n)
#pragma unroll
        for (int j = 0; j < 16; ++j) { const int k = 32 * mt + 8 * (j >> 2) + 4 * (lane >> 5) + (j & 3), v = 32 * (nb + n) + (lane & 31);
            ub[k * 256 + v] = acc[n][j]; }
    __syncthreads();
}
DEVI void gla_scan(const Params& P) {
    unsigned char* ws = P.ws;
    float* ust = (float*)(ws + O_UST); const float* dvec = (const float*)(ws + O_DVEC);
    const int e = (obid() * NT + otid()) * 4;
    const int dk = (e >> 15) * 128 + ((e >> 8) & 127);
    f32x4 st = {0.f, 0.f, 0.f, 0.f};
    for (int c0 = 0; c0 < 256; c0 += 8) {
        f32x4 u[8]; float d[8];
#pragma unroll
        for (int i = 0; i < 8; ++i) { u[i] = *(const f32x4*)(ust + (size_t)(c0 + i) * 131072 + e); d[i] = dvec[(c0 + i) * 512 + dk]; }
#pragma unroll
        for (int i = 0; i < 8; ++i) { *(f32x4*)(ust + (size_t)(c0 + i) * 131072 + e) = st; st = st * d[i] + u[i]; }
    }
}
DEVI void gla_out(LAS unsigned char* lds, const Params& P, int item) {
    unsigned char* ws = P.ws;
    const bf16_t* p = (const bf16_t*)(ws + O_P); const float* lg = (const float*)(ws + O_LG);
    const float* ust = (const float*)(ws + O_UST); bf16_t* mix = (bf16_t*)(ws + OFF_XN);
    const float* gnorm = P.in[31];
    const int chunk = item >> 2, head = item & 3, tid = otid(), wave = tid >> 6, lane = tid & 63;
    gla_bcum(lds, lg, chunk, head);
    const LAS float* L = (const LAS float*)(lds + G_SS);
    gla_load_v(lds, p, chunk, head);
#pragma unroll
    for (int u = 0; u < 2; ++u) { const int id = tid + NT * u, row = id >> 4, cc = id & 15;
        float fq[8], fk[8];
        unpack8(*(const u32x4*)(p + (size_t)(chunk * 64 + row) * ODD_LD + 3072 + head * 128 + cc * 8), fq);
        unpack8(*(const u32x4*)(p + (size_t)(chunk * 64 + row) * ODD_LD + 3584 + head * 128 + cc * 8), fk);
#pragma unroll
        for (int j = 0; j < 8; ++j) { const float bc = L[row * 128 + cc * 8 + j]; fq[j] *= 0.08838834764831845f * __expf(bc); fk[j] *= __expf(-bc); }
        *(LAS u32x4*)(lds + G_QS + row * G_LDQ + cc * 16) = pack8(fq);
        *(LAS u32x4*)(lds + G_KS + row * G_LDQ + cc * 16) = pack8(fk); }
    __syncthreads();
    {
        const float* sb = ust + (size_t)item * 128 * 256;
#pragma unroll
        for (int u = 0; u < 8; ++u) { const int id = tid + NT * u, row = id >> 5, cc = id & 31;
            const f32x4 a = *(const f32x4*)(sb + row * 256 + cc * 8), b = *(const f32x4*)(sb + row * 256 + cc * 8 + 4);
            u32x4 w; w.x = pk_bf16(a[0], a[1]); w.y = pk_bf16(a[2], a[3]); w.z = pk_bf16(b[0], b[1]); w.w = pk_bf16(b[2], b[3]);
            *(LAS u32x4*)(lds + G_SS + row * G_LDV + cc * 16) = w; }
    }
    if (wave < 4) {
        const int mt = wave >> 1, nt = wave & 1;
        f32x16 acc;
#pragma unroll
        for (int j = 0; j < 16; ++j) acc[j] = 0.f;
        {
            bf16x8 fa[3], fb[3];
#pragma unroll
            for (int ks = 0; ks < 2; ++ks) { fa[ks] = frag_rm(lds + G_QS, G_LDQ, 32 * mt, 16 * ks, lane); fb[ks] = frag_rm(lds + G_KS, G_LDQ, 32 * nt, 16 * ks, lane); }
            __builtin_amdgcn_sched_barrier(0);
#pragma unroll
            for (int ks = 0; ks < 8; ++ks) {
                if (ks + 2 < 8) { fa[(ks + 2) % 3] = frag_rm(lds + G_QS, G_LDQ, 32 * mt, 16 * (ks + 2), lane); fb[(ks + 2) % 3] = frag_rm(lds + G_KS, G_LDQ, 32 * nt, 16 * (ks + 2), lane); }
                __builtin_amdgcn_sched_barrier(0);
                acc = __builtin_amdgcn_mfma_f32_32x32x16_bf16(fa[ks % 3], fb[ks % 3], acc, 0, 0, 0);
                __builtin_amdgcn_sched_barrier(0);
            }
        }
#pragma unroll
        for (int j = 0; j < 16; ++j) { const int tt = 32 * mt + 8 * (j >> 2) + 4 * (lane >> 5) + (j & 3), s = 32 * nt + (lane & 31);
            *(LAS bf16_t*)(lds + G_AS + tt * G_LDA + s * 2) = f2bf(s <= tt ? acc[j] : 0.f); }
    }
    __syncthreads();
    f32x16 o[2];
#pragma unroll
    for (int m = 0; m < 2; ++m)
#pragma unroll
        for (int j = 0; j < 16; ++j) o[m][j] = 0.f;
    {
        bf16x8 fb[2], fa[2][2];
        auto ldstep = [&](int st, bf16x8& b, bf16x8& a0, bf16x8& a1) {
            if (st < 8) { b = frag_tr(lds + G_SS, G_LDV, 16 * st, 32 * wave, lane); a0 = frag_rm(lds + G_QS, G_LDQ, 0, 16 * st, lane); a1 = frag_rm(lds + G_QS, G_LDQ, 32, 16 * st, lane); }
            else { b = frag_tr(lds + G_VS, G_LDV, 16 * (st - 8), 32 * wave, lane); a0 = frag_rm(lds + G_AS, G_LDA, 0, 16 * (st - 8), lane); a1 = frag_rm(lds + G_AS, G_LDA, 32, 16 * (st - 8), lane); }
        };
        ldstep(0, fb[0], fa[0][0], fa[0][1]);
        __builtin_amdgcn_sched_barrier(0);
#pragma unroll
        for (int st = 0; st < 12; ++st) {
            if (st + 1 < 12) ldstep(st + 1, fb[(st + 1) & 1], fa[(st + 1) & 1][0], fa[(st + 1) & 1][1]);
            __builtin_amdgcn_sched_barrier(0);
            o[0] = __builtin_amdgcn_mfma_f32_32x32x16_bf16(fa[st & 1][0], fb[st & 1], o[0], 0, 0, 0);
            o[1] = __builtin_amdgcn_mfma_f32_32x32x16_bf16(fa[st & 1][1], fb[st & 1], o[1], 0, 0, 0);
            __builtin_amdgcn_sched_barrier(0);
        }
    }
    __syncthreads();
    LAS float* Ob = (LAS float*)(lds + G_SS);
#pragma unroll
    for (int m = 0; m < 2; ++m)
#pragma unroll
        for (int j = 0; j < 16; ++j) { const int tt = 32 * m + 8 * (j >> 2) + 4 * (lane >> 5) + (j & 3), v = 32 * wave + (lane & 31); Ob[tt * 260 + v] = o[m][j]; }
    __syncthreads();
    {
        const int row = tid >> 3, sub = tid & 7;
        float vals[32]; float ss = 0.f;
#pragma unroll
        for (int q = 0; q < 8; ++q) { const f32x4 x = *(const LAS f32x4*)(Ob + row * 260 + sub * 32 + q * 4);
#pragma unroll
            for (int e = 0; e < 4; ++e) { vals[q * 4 + e] = x[e]; ss += x[e] * x[e]; } }
        ss += __shfl_xor(ss, 1); ss += __shfl_xor(ss, 2); ss += __shfl_xor(ss, 4);
        const float r = rsqrtf(ss * (1.0f / 256) + 1e-6f);
        const size_t tok = (size_t)(chunk * 64 + row);
        const bf16_t* rd = p + tok * ODD_LD + 5136 + head * 256 + sub * 32;
        bf16_t* mo = mix + tok * 2048 + 1024 + head * 256 + sub * 32;
        const float* gw = gnorm + head * 256 + sub * 32;
        u32x4 gq[4]; f32x4 wq[8];
#pragma unroll
        for (int q = 0; q < 4; ++q) { gq[q] = *(const u32x4*)(rd + q * 8); wq[2 * q] = *(const f32x4*)(gw + q * 8); wq[2 * q + 1] = *(const f32x4*)(gw + q * 8 + 4); }
#pragma unroll
        for (int q = 0; q < 4; ++q) { float g[8], ov[8]; unpack8(gq[q], g);
#pragma unroll
            for (int e = 0; e < 8; ++e) ov[e] = vals[q * 8 + e] * r * wq[2 * q + (e >> 2)][e & 3] * siluf_(g[e]);
            *(u32x4*)(mo + q * 8) = pack8(ov); }
    }
    __syncthreads();
}

DEVI void omerge(const Params& P) {
    unsigned char* ws = P.ws;
    const bf16_t* opat = (const bf16_t*)(ws + O_OPAT); const float* lse = (const float*)(ws + O_LSE); bf16_t* mix = (bf16_t*)(ws + OFF_XN);
    const int wave = otid() >> 6, lane = otid() & 63;
    for (int t = obid() * 8 + wave; t < S; t += gridDim.x * 8) {
#pragma unroll
        for (int q = 0; q < 2; ++q) {
            const int c = (lane + 64 * q) * 8, head = c >> 7;
            const float l0 = lse[(size_t)t * 8 + head], l1 = lse[(SZ + t) * 8 + head], l2 = lse[(2 * SZ + t) * 8 + head];
            const float mx = fmaxf(l0, fmaxf(l1, l2));
            float w0 = __builtin_amdgcn_exp2f(l0 - mx), w1 = __builtin_amdgcn_exp2f(l1 - mx), w2 = __builtin_amdgcn_exp2f(l2 - mx);
            const float inv = __builtin_amdgcn_rcpf(w0 + w1 + w2); w0 *= inv; w1 *= inv; w2 *= inv;
            float a[8], b[8], d[8], o[8];
            unpack8(*(const u32x4*)(opat + (size_t)t * 1024 + c), a); unpack8(*(const u32x4*)(opat + (SZ + t) * 1024 + c), b); unpack8(*(const u32x4*)(opat + (2 * SZ + t) * 1024 + c), d);
#pragma unroll
            for (int e = 0; e < 8; ++e) o[e] = w0 * a[e] + w1 * b[e] + w2 * d[e];
            *(u32x4*)(mix + (size_t)t * 2048 + c) = pack8(o);
        }
    }
}

DEVI void oattn(LAS unsigned char* lds, const Params& P) {
    unsigned char* ws = P.ws;
    if (obid() < 64) gla_scan(P);
    const bf16_t* p = (const bf16_t*)(ws + O_P); bf16_t* opat = (bf16_t*)(ws + O_OPAT); float* lse = (float*)(ws + O_LSE);
    unsigned* cnt = (unsigned*)(ws + OFF_CNT) + 48;
    LAS int* slot = (LAS int*)(lds + LDS_BYTES - 16);
    const int xcd = (int)(xb_xcc_id() & 7u);
    for (;;) {
        if (otid() == 0) { int hsel = -1, nsel = 0;
            for (int k = 0; k < 8; ++k) { const int h = (xcd + k) & 7; const int n = (int)atomicAdd(cnt + h, 1u); if (n < 192) { hsel = h; nsel = n; break; } }
            slot[0] = hsel; slot[1] = nsel; }
        __syncthreads();
        const int head = slot[0], it = slot[1];
        __syncthreads();
        if (head < 0) break;
        const int pat = it >> 6, blk = it & 63;
        const int dil = pat == 0 ? 1 : (pat == 1 ? 4 : 16);
        const int per = 64 / dil;
        const int res = blk / per, i0 = (blk % per) * 256;
        attn_item<128, 1>(lds, p + head * 128, ODD_LD, p + 1024 + head * 128, ODD_LD, p + 2048 + head * 128, ODD_LD,
                          opat + (size_t)pat * SZ * 1024 + head * 128, 1024, lse + (size_t)pat * SZ * 8 + head, 8, i0, dil, res);
    }
}

#define XB_TMO      128
#define XB_XCNT(j)  (256  + 64 * (j))
#define XB_XSUB(j)  (1280 + 64 * (j))
#define XB_XGEN(j)  (2304 + 64 * (j))
#define XB_TOP      3328
#define XB_TOPGEN   3392
#define XCD_BAR_WORDS 3456
#define XB_SPIN_CAP (1u << 20)
DEVI unsigned xb_ld(unsigned* p) { return __hip_atomic_load(p, __ATOMIC_RELAXED, __HIP_MEMORY_SCOPE_AGENT); }
DEVI unsigned xb_add(unsigned* p, unsigned v) { return __hip_atomic_fetch_add(p, v, __ATOMIC_RELAXED, __HIP_MEMORY_SCOPE_AGENT); }
#define XB_SPIN(cond, bar) do { unsigned _sp = 0; while (cond) { __builtin_amdgcn_s_sleep(1); \
    if ((++_sp & 255u) == 0u) { if (xb_ld(&(bar)[XB_TMO])) break; if (_sp > XB_SPIN_CAP) { atomicAdd(&(bar)[XB_TMO], 1u); break; } } } } while (0)
struct XcdBarrier { unsigned* bar; unsigned x; volatile LAS unsigned* st; };
DEVI XcdBarrier xcd_barrier_post(unsigned* bar, volatile LAS unsigned* st) {
    XcdBarrier b; b.bar = bar; b.x = xb_xcc_id(); b.st = st;
    if (otid() == 0) (void)xb_add(&bar[XB_XCNT(b.x)], 1u);
    return b;
}
DEVI void xcd_barrier_complete(unsigned* bar, unsigned x, unsigned& nloc, unsigned& nx) {
    const unsigned G = gridDim.x;
    unsigned sum, cnt, mine, sp = 0u;
    for (;;) {
        sum = 0u; cnt = 0u; mine = 0u;
#pragma unroll
        for (unsigned j = 0; j < 16; ++j) { const unsigned c = xb_ld(&bar[XB_XCNT(j)]); sum += c; cnt += (c > 0u) ? 1u : 0u; mine = (j == x) ? c : mine; }
        if (sum == G) break;
        __builtin_amdgcn_s_sleep(1);
        if ((++sp & 255u) == 0u) { if (xb_ld(&bar[XB_TMO])) break; if (sp > XB_SPIN_CAP) { atomicAdd(&bar[XB_TMO], 1u); break; } }
    }
    nloc = mine > 0u ? mine : 1u; nx = cnt > 0u ? cnt : 1u;
}
DEVI void xcd_barrier(const XcdBarrier& b) {
    asm volatile("s_waitcnt vmcnt(0)" ::: "memory");
    __syncthreads();
    if (otid() == 0) {
        unsigned* bar = b.bar;
        __builtin_amdgcn_s_waitcnt(0);
        unsigned nloc = b.st[0], nx = b.st[1];
        if (nloc == 0u) { xcd_barrier_complete(bar, b.x, nloc, nx); b.st[0] = nloc; b.st[1] = nx; }
        const unsigned old = xb_add(&bar[XB_XSUB(b.x)], 1u);
        const unsigned gen = old / nloc;
        if (old + 1u == (gen + 1u) * nloc) {
            __builtin_amdgcn_fence(__ATOMIC_RELEASE, "agent");
            asm volatile("s_waitcnt vmcnt(0)" ::: "memory");
            const unsigned og = xb_add(&bar[XB_TOP], 1u);
            const unsigned tg = og / nx;
            if (og + 1u == (tg + 1u) * nx) xb_add(&bar[XB_TOPGEN], 1u);
            else XB_SPIN(xb_ld(&bar[XB_TOPGEN]) == tg, bar);
            __builtin_amdgcn_fence(__ATOMIC_ACQUIRE, "agent");
            xb_add(&bar[XB_XGEN(b.x)], 1u);
            asm volatile("s_waitcnt vmcnt(0)" ::: "memory");
        } else {
            XB_SPIN(xb_ld(&bar[XB_XGEN(b.x)]) == gen, bar);
            __builtin_amdgcn_fence(__ATOMIC_ACQUIRE, "agent");
            asm volatile("s_waitcnt vmcnt(0)" ::: "memory");
        }
    }
    __syncthreads();
}

template <int EPI> DEVI void run_gemm(LAS unsigned char* lds, const GemmDesc& d) {
    pg8::StaticOrder so; so.init(S, d.N, (int)gridDim.x, obid());
    if (EPI == 0) { pg8::EpiBf16 e{(bf16_t*)d.out, d.ldc, d.rs_in, d.rs_n}; pg8::gemm_phase(lds, d.A, d.Bt, d.lda, d.ldb, d.K, so, e); }
    else if (EPI == 1) { pg8::EpiSwiglu e{(bf16_t*)d.out, d.ldc, d.rs_in, d.rs_n}; pg8::gemm_phase(lds, d.A, d.Bt, d.lda, d.ldb, d.K, so, e); }
    else { pg8::EpiResid e{(float*)d.out, d.res, d.ldc, d.scale, d.hb_out, d.rs_out}; pg8::gemm_phase(lds, d.A, d.Bt, d.lda, d.ldb, d.K, so, e); }
}
enum { G_GU0 = 0, G_DN0, G_WINE, G_UQ, G_UKV, G_LORA, G_WOUTE, G_GU1, G_DN1, G_GU2, G_DN2, G_WINO, G_WOUTO, G_GU3, G_DN3 };
__global__ void __launch_bounds__(512, 2) hybrid_fwd(const Params P) {
    extern __shared__ __attribute__((aligned(16))) unsigned char smem[];
    LAS unsigned char* lds = (LAS unsigned char*)smem;
    cg::grid_group grid = cg::this_grid();
    volatile LAS unsigned* xst = (volatile LAS unsigned*)(lds + LDS_BYTES - 32);
    unsigned* xbar = (unsigned*)(P.ws + OFF_BAR);
    if (otid() == 0) { xst[0] = 0u; xst[1] = 0u; }
    if (obid() == 0) { for (int i = otid(); i < XCD_BAR_WORDS; i += NT) __hip_atomic_store(xbar + i, 0u, __ATOMIC_RELAXED, __HIP_MEMORY_SCOPE_AGENT); }
    __syncthreads();
#define SYNC() xcd_barrier(xb)
#define PH(k) if (PHMASK & (1 << (k)))
#define REP(bit) for (int rep_ = 0; rep_ < ((PROBE & (bit)) ? 2 : 1); ++rep_)
    REP(4) { PH(0) init_phase((LAS float*)lds, P); }
    REP(4) { PH(1) xprep_rows(P.in[0], (bf16_t*)(P.ws + OFF_XN), (float*)(P.ws + OFF_RS)); }
    grid.sync();
    const XcdBarrier xb = xcd_barrier_post(xbar, xst);
    REP(16) { PH(1) cvt_dn((LAS float*)lds, P, 0); }
    REP(1) { PH(2) run_gemm<1>(lds, P.gd[G_GU0]); SYNC(); }
    REP(16) { PH(1) cvt_gu((LAS float*)lds, P, 1); }
    REP(1) { PH(2) run_gemm<2>(lds, P.gd[G_DN0]); SYNC(); }
    REP(1) { PH(2) run_gemm<0>(lds, P.gd[G_WINE]); SYNC(); }
    REP(4) { PH(3) eprep1(P); SYNC(); }
    REP(1) { PH(2) { run_gemm<0>(lds, P.gd[G_UQ]); run_gemm<0>(lds, P.gd[G_UKV]); run_gemm<0>(lds, P.gd[G_LORA]); } SYNC(); }
    PH(4) eprep2(P); SYNC();
    REP(8) { PH(5) rwkv_A(lds, P); SYNC(); }
    REP(2) { PH(5) emix(lds, P); SYNC(); if (PROBE & 2) { if (obid() == 0 && otid() == 0) *(unsigned*)(P.ws + OFF_CNT) = 0u; SYNC(); } }
    REP(8) { PH(5) rwkv_C(lds, P); SYNC(); }
    REP(4) { PH(6) epost(P); SYNC(); }
    PH(2) run_gemm<2>(lds, P.gd[G_WOUTE]); SYNC();
    REP(16) { PH(1) cvt_dn((LAS float*)lds, P, 1); }
    REP(1) { PH(2) run_gemm<1>(lds, P.gd[G_GU1]); SYNC(); }
    REP(16) { PH(1) cvt_gu((LAS float*)lds, P, 2); }
    PH(2) run_gemm<2>(lds, P.gd[G_DN1]); SYNC();
    REP(16) { PH(1) cvt_dn((LAS float*)lds, P, 2); }
    REP(1) { PH(2) run_gemm<1>(lds, P.gd[G_GU2]); SYNC(); }
    REP(16) { PH(1) cvt_gu((LAS float*)lds, P, 3); }
    PH(2) run_gemm<2>(lds, P.gd[G_DN2]); SYNC();
    REP(1) { PH(2) run_gemm<0>(lds, P.gd[G_WINO]); SYNC(); }
    PH(7) oprep(P); SYNC();
    PH(8) { for (int it = obid(); it < 1024; it += gridDim.x) gla_local(lds, P, it); } SYNC();
    PH(8) oattn(lds, P); SYNC();
    REP(4) { PH(10) { for (int it = obid(); it < 1024; it += gridDim.x) gla_out(lds, P, it); omerge(P); } SYNC(); }
    PH(2) run_gemm<2>(lds, P.gd[G_WOUTO]); SYNC();
    REP(16) { PH(1) cvt_dn((LAS float*)lds, P, 3); }
    REP(1) { PH(2) run_gemm<1>(lds, P.gd[G_GU3]); SYNC(); }
    PH(2) run_gemm<2>(lds, P.gd[G_DN3]);
}

extern "C" void kernel_launch(void* const* d_in, const int* in_sizes, int n_in, void* d_out, int out_size, void* d_ws, size_t ws_size, hipStream_t stream) {
    static int grid_blocks = 0;
    if (!grid_blocks) {
        int dev = 0, cus = 0, per_cu = 0;
        hipGetDevice(&dev);
        hipDeviceGetAttribute(&cus, hipDeviceAttributeMultiprocessorCount, dev);
        hipFuncSetAttribute((const void*)hybrid_fwd, hipFuncAttributeMaxDynamicSharedMemorySize, LDS_BYTES);
        hipOccupancyMaxActiveBlocksPerMultiprocessor(&per_cu, hybrid_fwd, NT, LDS_BYTES);
        if (per_cu < 1) per_cu = 1;
        grid_blocks = cus * 1;
        if (ws_size < WS_NEED) fprintf(stderr, "workspace too small: %zu < %zu\n", ws_size, (size_t)WS_NEED);
    }
    Params P; memset(&P, 0, sizeof(P));
    for (int i = 0; i < 33; ++i) P.in[i] = (const float*)d_in[i];
    P.out = (float*)d_out; P.ws = (unsigned char*)d_ws;
    unsigned char* ws = (unsigned char*)d_ws;
    auto B = [&](size_t off) { return (const bf16_t*)(ws + off); };
    int ng = 0;
    float* rsA = (float*)(ws + OFF_RS); float* rsB = rsA + (size_t)S * 32;
    auto gemm = [&](const bf16_t* A, int lda, const bf16_t* Bt, int ldb, int N, int K, int epi, void* out, int ldc, const float* res, float scale,
                    const float* rs_in, int rs_n, float* rs_out, bf16_t* hb_out) {
        GemmDesc& g = P.gd[ng]; g.A = A; g.Bt = Bt; g.out = out; g.res = res; g.rs_in = rs_in; g.rs_out = rs_out; g.hb_out = hb_out;
        g.lda = lda; g.ldb = ldb; g.ldc = ldc; g.N = N; g.K = K; g.epi = epi; g.scale = scale; g.rs_n = rs_n; return ng++; };
    bf16_t* XN = (bf16_t*)(ws + OFF_XN); bf16_t* HB = (bf16_t*)(ws + OFF_HB);
    const float* fout = (const float*)d_out;
    gemm(XN, DM, B(OFF_GUT), DM, 2 * DFF, DM, 1, ws + OFF_HID, DFF, nullptr, 0.f, rsA, 1, nullptr, nullptr);
    gemm(B(OFF_HID), DFF, B(OFF_DT), DFF, DM, DFF, 2, d_out, DM, (const float*)d_in[0], 0.5f, nullptr, 0, rsB, XN);
    gemm(XN, DM, B(OFF_WINE), DM, EVEN_LD, DM, 0, ws + E_P, EVEN_LD, nullptr, 0.f, rsB, 32, nullptr, nullptr);
    gemm(B(E_CQN), 512, B(OFF_WUQ), 512, 1536, 512, 0, ws + E_Q, 1536, nullptr, 0.f, nullptr, 0, nullptr, nullptr);
    gemm(B(E_CKVN), 256, B(OFF_WUKV), 256, 2048, 256, 0, ws + E_KV, 2048, nullptr, 0.f, nullptr, 0, nullptr, nullptr);
    gemm(B(E_LIN), 384, B(OFF_LORA), 384, 3072, 384, 0, ws + E_LOUT, 3072, nullptr, 0.f, nullptr, 0, nullptr, nullptr);
    gemm(XN, DM, B(OFF_WOUTE), DM, DM, DM, 2, d_out, DM, fout, 1.0f, nullptr, 0, rsB, HB);
    gemm(HB, DM, B(OFF_GUT), DM, 2 * DFF, DM, 1, ws + OFF_HID, DFF, nullptr, 0.f, rsB, 32, nullptr, nullptr);
    gemm(B(OFF_HID), DFF, B(OFF_DT), DFF, DM, DFF, 2, d_out, DM, fout, 0.5f, nullptr, 0, rsB, XN);
    gemm(XN, DM, B(OFF_GUT), DM, 2 * DFF, DM, 1, ws + OFF_HID, DFF, nullptr, 0.f, rsB, 32, nullptr, nullptr);
    gemm(B(OFF_HID), DFF, B(OFF_DT), DFF, DM, DFF, 2, d_out, DM, fout, 0.5f, nullptr, 0, rsB, XN);
    gemm(XN, DM, B(OFF_WINO), DM, ODD_LD, DM, 0, ws + O_P, ODD_LD, nullptr, 0.f, rsB, 32, nullptr, nullptr);
    gemm(XN, DM, B(OFF_WOUTO), DM, DM, DM, 2, d_out, DM, fout, 1.0f, nullptr, 0, rsB, HB);
    gemm(HB, DM, B(OFF_GUT), DM, 2 * DFF, DM, 1, ws + OFF_HID, DFF, nullptr, 0.f, rsB, 32, nullptr, nullptr);
    gemm(B(OFF_HID), DFF, B(OFF_DT), DFF, DM, DFF, 2, d_out, DM, fout, 0.5f, nullptr, 0, nullptr, nullptr);
    P.nsteps = 0;
    void* args[] = {&P};
    hipError_t e = hipLaunchCooperativeKernel((const void*)hybrid_fwd, dim3(grid_blocks), dim3(NT), args, LDS_BYTES, stream);
    if (e != hipSuccess) fprintf(stderr, "cooperative launch failed: %s (grid %d)\n", hipGetErrorString(e), grid_blocks);
}
```
